# Optimizing an MI355X kernel written in HIP

```python
import math
import jax, jax.numpy as jnp
from jax import lax
import numpy as np

D_MODEL = 1024
BATCH = 1
SEQ = 16384
DEPTH = 4

N_MIXERS = 2
ROPE_THETA = 500000.0
LN_EPS = 1e-5
RMS_EPS = 1e-6

MLA_HEADS = 8
MLA_NOPE = 128
MLA_ROPE = 64
MLA_V = 128
MLA_Q_RANK = 384
MLA_KV_RANK = 256
MLA_QBLOCK = 128

SWA_HEADS = 16
SWA_KV_HEADS = 4
SWA_HEAD_DIM = 64
SWA_WINDOW = 128
SWA_ROT = SWA_HEAD_DIM // 4

D_FF = ((8 * D_MODEL + 3 * 256 - 1) // (3 * 256)) * 256

DEEPNORM_ALPHA = (2 * DEPTH) ** 0.25
DEEPNORM_BETA = (8 * DEPTH) ** -0.25

N_MLA = (DEPTH + 1) // 2
N_SWA = DEPTH // 2

kernel_name = "hybrid_mla_swa_sink_deepnorm_adaln"


def layer_norm(x, g, b):
    xf = x.astype(jnp.float32)
    mu = jnp.mean(xf, -1, keepdims=True)
    var = jnp.mean(jnp.square(xf - mu), -1, keepdims=True)
    return ((xf - mu) * lax.rsqrt(var + LN_EPS) * g + b).astype(x.dtype)


def rms_norm(x, g):
    xf = x.astype(jnp.float32)
    return (xf * lax.rsqrt(jnp.mean(jnp.square(xf), -1, keepdims=True) + RMS_EPS) * g).astype(x.dtype)


def rope_cos_sin(positions, rot_dim):
    inv = ROPE_THETA ** (-jnp.arange(0, rot_dim, 2, dtype=jnp.float32) / rot_dim)
    ang = positions.astype(jnp.float32)[..., None] * inv
    return jnp.cos(ang), jnp.sin(ang)


def apply_rope(x, cos, sin):
    half = x.shape[-1] // 2
    x1, x2 = x[..., :half], x[..., half:]
    c = cos[:, :, None, :]
    s = sin[:, :, None, :]
    return jnp.concatenate([x1 * c - x2 * s, x2 * c + x1 * s], -1).astype(x.dtype)


def mla_mixer(h, cos, sin, w_in, q_norm, w_q_b, kv_norm, w_kv_b, w_o):
    B, S, _ = h.shape
    H = MLA_HEADS
    lat = h @ w_in
    q_lat = lat[..., :MLA_Q_RANK]
    kv_lat = lat[..., MLA_Q_RANK:MLA_Q_RANK + MLA_KV_RANK]
    k_rope = lat[..., MLA_Q_RANK + MLA_KV_RANK:]
    q = (rms_norm(q_lat, q_norm) @ w_q_b).reshape(B, S, H, MLA_NOPE + MLA_ROPE)
    q_nope = q[..., :MLA_NOPE]
    q_rope = apply_rope(q[..., MLA_NOPE:], cos, sin)
    k_rope = apply_rope(k_rope[:, :, None, :], cos, sin)[:, :, 0, :]
    kv = (rms_norm(kv_lat, kv_norm) @ w_kv_b).reshape(B, S, H, MLA_NOPE + MLA_V)
    k_nope = kv[..., :MLA_NOPE]
    v = kv[..., MLA_NOPE:]
    scale = (MLA_NOPE + MLA_ROPE) ** -0.5
    nb = S // MLA_QBLOCK
    qn_b = q_nope.reshape(B, nb, MLA_QBLOCK, H, MLA_NOPE).transpose(1, 0, 2, 3, 4)
    qr_b = q_rope.reshape(B, nb, MLA_QBLOCK, H, MLA_ROPE).transpose(1, 0, 2, 3, 4)
    starts = jnp.arange(nb, dtype=jnp.int32) * MLA_QBLOCK
    k_idx = jnp.arange(S, dtype=jnp.int32)

    def q_block(args):
        qn, qr, start = args
        s = (jnp.einsum('bqhd,bkhd->bhqk', qn, k_nope, preferred_element_type=jnp.float32)
             + jnp.einsum('bqhr,bkr->bhqk', qr, k_rope, preferred_element_type=jnp.float32)) * scale
        q_idx = start + jnp.arange(MLA_QBLOCK, dtype=jnp.int32)
        causal = k_idx[None, :] <= q_idx[:, None]
        s = jnp.where(causal[None, None], s, -jnp.inf)
        p = jax.nn.softmax(s, axis=-1).astype(v.dtype)
        return jnp.einsum('bhqk,bkhd->bqhd', p, v)

    o = lax.map(q_block, (qn_b, qr_b, starts))
    o = o.transpose(1, 0, 2, 3, 4).reshape(B, S, H * MLA_V)
    return o @ w_o


def partial_rope(x, cos, sin):
    return jnp.concatenate([apply_rope(x[..., :SWA_ROT], cos, sin), x[..., SWA_ROT:]], -1)


def swa_mixer(h, cos, sin, w_qkv, b_qkv, sinks, w_o, b_o):
    B, S, _ = h.shape
    HQ, HKV, HD, W = SWA_HEADS, SWA_KV_HEADS, SWA_HEAD_DIM, SWA_WINDOW
    G = HQ // HKV
    qkv = h @ w_qkv + b_qkv
    q = qkv[..., :HQ * HD].reshape(B, S, HQ, HD)
    k = qkv[..., HQ * HD:(HQ + HKV) * HD].reshape(B, S, HKV, HD)
    v = qkv[..., (HQ + HKV) * HD:].reshape(B, S, HKV, HD)
    q = partial_rope(q, cos, sin)
    k = partial_rope(k, cos, sin)
    nb = S // W
    qb = q.reshape(B, nb, W, HKV, G, HD)
    kb = k.reshape(B, nb, W, HKV, HD)
    vb = v.reshape(B, nb, W, HKV, HD)
    kpad = jnp.zeros_like(kb[:, :1])
    vpad = jnp.zeros_like(vb[:, :1])
    k2 = jnp.concatenate([jnp.concatenate([kpad, kb[:, :-1]], 1), kb], axis=2)
    v2 = jnp.concatenate([jnp.concatenate([vpad, vb[:, :-1]], 1), vb], axis=2)
    s = jnp.einsum('bnqhgd,bnkhd->bnhgqk', qb, k2, preferred_element_type=jnp.float32) * (HD ** -0.5)
    q_pos = jnp.arange(W, dtype=jnp.int32)[:, None] + W
    k_pos = jnp.arange(2 * W, dtype=jnp.int32)[None, :]
    rel = q_pos - k_pos
    band = (rel >= 0) & (rel < W)
    has_prev = (jnp.arange(nb)[:, None, None] > 0) | (k_pos[None] >= W)
    mask = band[None] & has_prev
    s = jnp.where(mask[None, :, None, None], s, -jnp.inf)
    sink = jnp.broadcast_to(sinks.astype(jnp.float32).reshape(HKV, G)[None, None, :, :, None, None],
                            s.shape[:-1] + (1,))
    p = jax.nn.softmax(jnp.concatenate([s, sink], -1), axis=-1)[..., :-1]
    o = jnp.einsum('bnhgqk,bnkhd->bnqhgd', p.astype(v.dtype), v2).reshape(B, S, HQ * HD)
    return o @ w_o + b_o


def swiglu(h, w_gate, w_up, w_down):
    return (jax.nn.silu(h @ w_gate) * (h @ w_up)) @ w_down


def setup_inputs(seed: int = 0) -> dict:
    key = jax.random.key(seed)
    ks = iter(jax.random.split(key, 32))
    D, F = D_MODEL, D_FF
    nrm = lambda shape, std: jax.random.normal(next(ks), shape, jnp.float32) * std
    offs = jax.random.randint(next(ks), (BATCH, 1), 0, 4096, dtype=jnp.int32)
    positions = offs + jnp.arange(SEQ, dtype=jnp.int32)[None, :]
    mla_in_w = MLA_Q_RANK + MLA_KV_RANK + MLA_ROPE
    swa_qkv_w = (SWA_HEADS + 2 * SWA_KV_HEADS) * SWA_HEAD_DIM
    return {
        "x": nrm((BATCH, SEQ, D), 1.0),
        "c": nrm((BATCH, D), 1.0),
        "positions": positions,
        "ada_w": nrm((DEPTH, D, 6 * D), 0.5 * D ** -0.5),
        "ada_b": nrm((DEPTH, 6 * D), 0.02),
        "ln_mix_g": 1.0 + nrm((DEPTH, D), 0.02),
        "ln_mix_b": nrm((DEPTH, D), 0.02),
        "ln_ffn_g": 1.0 + nrm((DEPTH, D), 0.02),
        "ln_ffn_b": nrm((DEPTH, D), 0.02),
        "ffn_w_gate": nrm((DEPTH, D, F), D ** -0.5),
        "ffn_w_up": nrm((DEPTH, D, F), D ** -0.5),
        "ffn_w_down": nrm((DEPTH, F, D), F ** -0.5 * DEEPNORM_BETA),
        "mla_w_in": nrm((N_MLA, D, mla_in_w), D ** -0.5),
        "mla_q_norm": 1.0 + nrm((N_MLA, MLA_Q_RANK), 0.02),
        "mla_w_q_b": nrm((N_MLA, MLA_Q_RANK, MLA_HEADS * (MLA_NOPE + MLA_ROPE)), MLA_Q_RANK ** -0.5),
        "mla_kv_norm": 1.0 + nrm((N_MLA, MLA_KV_RANK), 0.02),
        "mla_w_kv_b": nrm((N_MLA, MLA_KV_RANK, MLA_HEADS * (MLA_NOPE + MLA_V)), MLA_KV_RANK ** -0.5),
        "mla_w_o": nrm((N_MLA, MLA_HEADS * MLA_V, D), (MLA_HEADS * MLA_V) ** -0.5 * DEEPNORM_BETA),
        "swa_w_qkv": nrm((N_SWA, D, swa_qkv_w), D ** -0.5),
        "swa_b_qkv": nrm((N_SWA, swa_qkv_w), 0.02),
        "swa_sinks": nrm((N_SWA, SWA_HEADS), 1.0),
        "swa_w_o": nrm((N_SWA, SWA_HEADS * SWA_HEAD_DIM, D), (SWA_HEADS * SWA_HEAD_DIM) ** -0.5 * DEEPNORM_BETA),
        "swa_b_o": nrm((N_SWA, D), 0.02),
    }


def reference(x, c, positions, ada_w, ada_b, ln_mix_g, ln_mix_b, ln_ffn_g, ln_ffn_b,
              ffn_w_gate, ffn_w_up, ffn_w_down, mla_w_in, mla_q_norm, mla_w_q_b, mla_kv_norm,
              mla_w_kv_b, mla_w_o, swa_w_qkv, swa_b_qkv, swa_sinks, swa_w_o, swa_b_o):
    cos_a, sin_a = rope_cos_sin(positions, MLA_ROPE)
    cos_b, sin_b = rope_cos_sin(positions, SWA_ROT)
    cond = jax.nn.silu(c)
    for i in range(DEPTH):
        mod = (cond @ ada_w[i] + ada_b[i])[:, None, :]
        sh_m, sc_m, g_m, sh_f, sc_f, g_f = jnp.split(mod, 6, axis=-1)
        h = x * (1.0 + sc_m) + sh_m
        j = i // N_MIXERS
        if i % N_MIXERS == 0:
            y = mla_mixer(h, cos_a, sin_a, mla_w_in[j], mla_q_norm[j], mla_w_q_b[j],
                          mla_kv_norm[j], mla_w_kv_b[j], mla_w_o[j])
        else:
            y = swa_mixer(h, cos_b, sin_b, swa_w_qkv[j], swa_b_qkv[j], swa_sinks[j],
                          swa_w_o[j], swa_b_o[j])
        x = layer_norm(DEEPNORM_ALPHA * x + g_m * y, ln_mix_g[i], ln_mix_b[i])
        h = x * (1.0 + sc_f) + sh_f
        y = swiglu(h, ffn_w_gate[i], ffn_w_up[i], ffn_w_down[i])
        x = layer_norm(DEEPNORM_ALPHA * x + g_f * y, ln_ffn_g[i], ln_ffn_b[i])
    return x
```

```cpp
#include <hip/hip_runtime.h>
#include <hip/hip_cooperative_groups.h>
#include <cstdio>
#include <cstdint>
namespace cg = cooperative_groups;

typedef unsigned short bf16_t;
typedef short bf16x8 __attribute__((ext_vector_type(8)));
typedef short s16x4 __attribute__((ext_vector_type(4)));
typedef float f32x16 __attribute__((ext_vector_type(16)));
typedef __bf16 bf16x2_t __attribute__((ext_vector_type(2)));
typedef float f32x2_t __attribute__((ext_vector_type(2)));
typedef unsigned u32x4 __attribute__((ext_vector_type(4)));
typedef float f32x4 __attribute__((ext_vector_type(4)));

#define DI __device__ __forceinline__
#define LDSP __attribute__((address_space(3)))
#define MFMA32(a, b, c) __builtin_amdgcn_mfma_f32_32x32x16_bf16((a), (b), (c), 0, 0, 0)

#ifndef R_ATT
#define R_ATT 1
#endif
#ifndef R_F1
#define R_F1 1
#endif
#ifndef R_F2
#define R_F2 1
#endif
constexpr int S = 16384, D = 1024, F = 2816, DEPTH = 4;
constexpr int NT = 512;
constexpr int LDS_BYTES = 131072;
constexpr float ALPHA = 1.681792830507429f;
constexpr float LOG2E = 1.4426950408889634f;
constexpr float LOG2THETA = 18.931568569324174f;
constexpr float QS_MLA = 0.07216878364870322f * LOG2E;
constexpr float QS_SWA = 0.125f * LOG2E;

constexpr size_t MiB = 1048576;
constexpr size_t WS_MOD = 4096;
constexpr size_t WS_BAR = 131072;
constexpr size_t WS_RINV = 262144;
constexpr size_t WS_ID = 393216;
constexpr size_t WS_STATS = 524288;
constexpr size_t WS_XZ = 1 * MiB;
constexpr size_t WS_H = WS_XZ + 64 * MiB;
constexpr size_t WS_W = WS_H + 32 * MiB;
constexpr size_t WS_U = WS_W + 88 * MiB;
constexpr size_t WS_END = WS_U + 184 * MiB;
constexpr size_t U_LAT = 0;
constexpr size_t U_Q = 24 * MiB;
constexpr size_t U_K = 72 * MiB;
constexpr size_t U_VT = 120 * MiB;
constexpr size_t U_O = 152 * MiB;
constexpr size_t U_ACT = 0;
constexpr size_t FFN_L = 8650752, W_DN_OFF = 5767168;
constexpr size_t MLA_BASE = 4 * FFN_L, MLA_L = 2949120, W_QB_OFF = 786432, W_KVB_OFF = 1376256, W_MO_OFF = 1900544;
constexpr size_t SWA_BASE = MLA_BASE + 2 * MLA_L, SWA_L = 2621440, W_SO_OFF = 1572864;

struct Params {
  const float* x; const float* c; const int* pos;
  const float* ada_w; const float* ada_b;
  const float* ln_mix_g; const float* ln_mix_b; const float* ln_ffn_g; const float* ln_ffn_b;
  const float* ffn_w_gate; const float* ffn_w_up; const float* ffn_w_down;
  const float* mla_w_in; const float* mla_q_norm; const float* mla_w_q_b; const float* mla_kv_norm; const float* mla_w_kv_b; const float* mla_w_o;
  const float* swa_w_qkv; const float* swa_b_qkv; const float* swa_sinks; const float* swa_w_o; const float* swa_b_o;
  float* out; unsigned char* ws;
};

DI unsigned pk_bf16(float lo, float hi) { f32x2_t v = {lo, hi}; return __builtin_bit_cast(unsigned, __builtin_convertvector(v, bf16x2_t)); }
DI uint2 pack4(float a, float b, float c, float d) { uint2 u; u.x = pk_bf16(a, b); u.y = pk_bf16(c, d); return u; }
DI bf16_t f2bf(float x) { return (bf16_t)(pk_bf16(x, 0.f) & 0xffffu); }
DI int lane_id() { return (int)__builtin_amdgcn_mbcnt_hi(~0u, __builtin_amdgcn_mbcnt_lo(~0u, 0u)); }
#define TID (g_wave * 64 + lane_id())
DI float shx(float v, int m, int lane) { return __int_as_float(__builtin_amdgcn_ds_bpermute((lane ^ m) << 2, __float_as_int(v))); }
DI int crow(int i, int h) { return (i & 3) + 8 * (i >> 2) + 4 * h; }
DI float bf_lo(unsigned u) { return __uint_as_float(u << 16); }
DI float bf_hi(unsigned u) { return __uint_as_float(u & 0xffff0000u); }

DI void fast_sincos(float ang, float& s, float& c) {
  float n = rintf(ang * 0.15915494309189535f);
  float rr = fmaf(-n, 6.28125f, ang);
  rr = fmaf(-n, 1.9353071795864769e-3f, rr);
  s = __sinf(rr); c = __cosf(rr);
}

struct EpiArgs {
  bf16_t* o0; bf16_t* o1; bf16_t* o2;
  float* xz; const float* xsrc; const float* gate; const float* bias;
  const int* pos; const float* rinv;
  const float* stats; const float* lng; const float* lnb;
};
enum { E_LAT = 0, E_Q = 1, E_KN = 2, E_V = 6, E_RES = 3, E_SWIGLU = 4, E_QK = 5, E_SV = 7 };

#define MFMA16(a, b, c) __builtin_amdgcn_mfma_f32_16x16x32_bf16((a), (b), (c), 0, 0, 0)

DI void tile_map(int L, int nM, int nN, int& pm, int& pn) {
  const int nwg = nM * nN, q = nwg >> 3, r = nwg & 7, xcd = L & 7, off = L >> 3;
  const int wgid = (xcd < r ? xcd * (q + 1) : r * (q + 1) + (xcd - r) * q) + off;
  const int nig = 8 * nN, gid = wgid / nig, fm = gid * 8;
  const int gsz = (nM - fm) < 8 ? (nM - fm) : 8;
  pm = fm + ((wgid % nig) % gsz); pn = (wgid % nig) / gsz;
}

template <int EPI, int MT = 8>
DI void gemm_tile(const bf16_t* __restrict__ A, int lda, const bf16_t* __restrict__ Bt, int ldb, int K, int m0, int n0,
                  unsigned char* lds, const EpiArgs& e, const int g_wave, const bool preloaded = false, const int nm0 = -1, const int nn0 = 0) {
  int tid_ = TID;
  asm volatile("" : "+v"(tid_));
  const int tid = tid_, wid = tid >> 6, lane = tid & 63, wr = wid >> 2, wc = wid & 3, fr = lane & 15, fq = lane >> 4;
  constexpr bool SWAP = !(EPI == E_V || EPI == E_SV);
  f32x4 acc[MT][4];
#pragma unroll
  for (int m = 0; m < MT; ++m)
#pragma unroll
    for (int n = 0; n < 4; ++n) { acc[m][n][0] = 0.f; acc[m][n][1] = 0.f; acc[m][n][2] = 0.f; acc[m][n][3] = 0.f; }
  const int sbyte = lane * 16, swz = sbyte ^ (((sbyte >> 9) & 1) << 5);
  const int R0 = (wid >> 1) * 16 + (swz >> 6), C0 = (wid & 1) * 32 + ((swz & 63) >> 1);
  const bf16_t* Ab = A + (size_t)m0 * lda;
  const bf16_t* Bb = Bt + (size_t)n0 * ldb;
  const unsigned aoff = (unsigned)(R0 * lda + C0), boff = (unsigned)(R0 * ldb + C0);
  const int lrd = fr * 64 + ((fq * 16) ^ ((fr >> 3) << 5));
  const int lbase = wid * 1024;
#define G_STAGE(buf, kt) do { _Pragma("unroll") for (int i = 0; i < 4; ++i) { \
    if (i < MT / 2) __builtin_amdgcn_global_load_lds((const unsigned*)(Ab + (aoff + (unsigned)(64 * i * lda) + (unsigned)((kt) * 64))), \
        (LDSP unsigned*)(lds + (buf) * 65536 + lbase + i * 8192), 16, 0, 0); \
    __builtin_amdgcn_global_load_lds((const unsigned*)(Bb + (boff + (unsigned)(64 * i * ldb) + (unsigned)((kt) * 64))), \
        (LDSP unsigned*)(lds + (buf) * 65536 + 32768 + lbase + i * 8192), 16, 0, 0); } __builtin_amdgcn_sched_barrier(0); } while (0)
  const int nt = K >> 6;
  const bool late = __builtin_amdgcn_readfirstlane(tid >> 8) != 0;
  if (!preloaded) {
    G_STAGE(0, 0);
    asm volatile("s_waitcnt vmcnt(0)" ::: "memory");
    __syncthreads();
  }
#define G_KSTEP(ks) do { \
      bf16x8 Bf[4], At[MT]; \
      _Pragma("unroll") for (int n = 0; n < 4; ++n) Bf[n] = *(const bf16x8*)(pb + (n * 2 + (ks)) * 1024); \
      _Pragma("unroll") for (int m = 0; m < MT; ++m) At[m] = *(const bf16x8*)(pa + (m * 2 + (ks)) * 1024); \
      _Pragma("unroll") for (int m = 0; m < MT; ++m) \
      _Pragma("unroll") for (int n = 0; n < 4; ++n) acc[m][n] = SWAP ? MFMA16(Bf[n], At[m], acc[m][n]) : MFMA16(At[m], Bf[n], acc[m][n]); \
      __builtin_amdgcn_sched_group_barrier(0x100, 9, 0); \
      _Pragma("unroll") for (int m = 0; m < MT; ++m) { \
        __builtin_amdgcn_sched_group_barrier(0x008, 4, 0); \
        if (m < MT - 5) __builtin_amdgcn_sched_group_barrier(0x100, 1, 0); } \
      __builtin_amdgcn_sched_barrier(0); } while (0)
  for (int t = 0; t < nt; ++t) {
    const int cur = t & 1;
    const unsigned char* pa = lds + cur * 65536 + wr * (MT * 2048) + lrd;
    const unsigned char* pb = lds + cur * 65536 + 32768 + wc * 8192 + lrd;
    const bool lastk = (t + 1 == nt);
    if (lastk && nm0 >= 0) { Ab = A + (size_t)nm0 * lda; Bb = Bt + (size_t)nn0 * ldb; }
    const bool dost = !lastk || nm0 >= 0;
    const int kst = lastk ? 0 : t + 1;
    if (!late) { if (dost) G_STAGE(cur ^ 1, kst); }
    __builtin_amdgcn_sched_barrier(0);
    __builtin_amdgcn_s_setprio(3);
    G_KSTEP(0);
    __builtin_amdgcn_s_setprio(0);
    if (late) { if (dost) G_STAGE(cur ^ 1, kst); }
    __builtin_amdgcn_sched_barrier(0);
    __builtin_amdgcn_s_setprio(3);
    G_KSTEP(1);
    __builtin_amdgcn_s_setprio(0);
    asm volatile("s_waitcnt vmcnt(0)" ::: "memory");
    __syncthreads();
  }
#undef G_STAGE
#undef G_KSTEP
  int fr_e = lane & 15, fq_e = lane >> 4;
  asm volatile("" : "+v"(fr_e), "+v"(fq_e));
  const int n0g = n0 + wc * 64;
  if constexpr (SWAP) {
    const int rb = m0 + wr * (MT * 16) + fr_e;
    const int cq = fq_e * 4;
    if constexpr (EPI == E_LAT) {
      if (n0g < 704) {
#pragma unroll
        for (int m = 0; m < MT; ++m)
#pragma unroll
          for (int n = 0; n < 4; ++n)
            *(uint2*)(e.o0 + (size_t)(rb + m * 16) * 768 + n0g + n * 16 + cq) = pack4(acc[m][n][0], acc[m][n][1], acc[m][n][2], acc[m][n][3]);
      }
    } else if constexpr (EPI == E_Q) {
      const bool is_rope = (n0g % 192) == 128;
      float inv[2][4];
#pragma unroll
      for (int n = 0; n < 2; ++n)
#pragma unroll
        for (int j = 0; j < 4; ++j) inv[n][j] = exp2f(-(float)(n * 16 + cq + j) * (1.0f / 32.0f) * LOG2THETA);
#pragma unroll
      for (int m = 0; m < MT; ++m) {
        const int row = rb + m * 16;
        const float ri = e.rinv[row] * QS_MLA;
        float v[4][4];
#pragma unroll
        for (int n = 0; n < 4; ++n)
#pragma unroll
          for (int j = 0; j < 4; ++j) v[n][j] = acc[m][n][j] * ri;
        if (is_rope) {
          const float pf = (float)e.pos[row];
#pragma unroll
          for (int n = 0; n < 2; ++n)
#pragma unroll
            for (int j = 0; j < 4; ++j) {
              float sn, cs;
              fast_sincos(pf * inv[n][j], sn, cs);
              const float y0 = v[n][j] * cs - v[n + 2][j] * sn, y1 = v[n + 2][j] * cs + v[n][j] * sn;
              v[n][j] = y0; v[n + 2][j] = y1;
            }
        }
#pragma unroll
        for (int n = 0; n < 4; ++n) *(uint2*)(e.o0 + (size_t)row * 1536 + n0g + n * 16 + cq) = pack4(v[n][0], v[n][1], v[n][2], v[n][3]);
      }
    } else if constexpr (EPI == E_KN) {
      const int hd = n0g >> 7, cb = n0g & 127;
#pragma unroll
      for (int m = 0; m < MT; ++m) {
        const int row = rb + m * 16;
        const float ri = e.rinv[row];
#pragma unroll
        for (int n = 0; n < 4; ++n)
          *(uint2*)(e.o1 + ((size_t)hd * S + row) * 192 + cb + n * 16 + cq) = pack4(acc[m][n][0] * ri, acc[m][n][1] * ri, acc[m][n][2] * ri, acc[m][n][3] * ri);
      }
    } else if constexpr (EPI == E_RES) {
#pragma unroll
      for (int n = 0; n < 4; ++n) {
        const int col = n0g + n * 16 + cq;
        const float4 g4 = *(const float4*)(e.gate + col);
        float4 b4 = {0.f, 0.f, 0.f, 0.f};
        if (e.bias) b4 = *(const float4*)(e.bias + col);
        float4 lg = *(const float4*)(e.lng + col), lb = *(const float4*)(e.lnb + col);
        lg.x *= ALPHA; lg.y *= ALPHA; lg.z *= ALPHA; lg.w *= ALPHA; lb.x *= ALPHA; lb.y *= ALPHA; lb.z *= ALPHA; lb.w *= ALPHA;
#pragma unroll
        for (int m = 0; m < MT; ++m) {
          const size_t idx = (size_t)(rb + m * 16) * D + col;
          const float4 z4 = *(const float4*)(e.xsrc + idx);
          const float2 st2 = *(const float2*)(e.stats + (size_t)(rb + m * 16) * 2);
          float4 o4;
          o4.x = (z4.x - st2.x) * st2.y * lg.x + lb.x + g4.x * (acc[m][n][0] + b4.x); o4.y = (z4.y - st2.x) * st2.y * lg.y + lb.y + g4.y * (acc[m][n][1] + b4.y);
          o4.z = (z4.z - st2.x) * st2.y * lg.z + lb.z + g4.z * (acc[m][n][2] + b4.z); o4.w = (z4.w - st2.x) * st2.y * lg.w + lb.w + g4.w * (acc[m][n][3] + b4.w);
          *(float4*)(e.xz + idx) = o4;
        }
      }
    } else if constexpr (EPI == E_SWIGLU) {
      const int oc = (n0g >> 1) + cq;
#pragma unroll
      for (int m = 0; m < MT; ++m) {
        const int row = rb + m * 16;
#pragma unroll
        for (int n = 0; n < 2; ++n) {
          float a4[4];
#pragma unroll
          for (int j = 0; j < 4; ++j) {
            const float g = acc[m][n][j];
            a4[j] = g * __builtin_amdgcn_rcpf(1.f + __builtin_amdgcn_exp2f(-g * LOG2E)) * acc[m][n + 2][j];
          }
          *(uint2*)(e.o0 + (size_t)row * F + oc + n * 16) = pack4(a4[0], a4[1], a4[2], a4[3]);
        }
      }
    } else if constexpr (EPI == E_QK) {
      float4 bv[4];
#pragma unroll
      for (int n = 0; n < 4; ++n) bv[n] = *(const float4*)(e.bias + n0g + n * 16 + cq);
      float inv[4];
#pragma unroll
      for (int j = 0; j < 4; ++j) inv[j] = exp2f(-(float)(((fq_e & 1) * 4) + j) * 0.125f * LOG2THETA);
      const bool isq = n0g < 1024;
      const float qs = isq ? QS_SWA : 1.0f;
      bf16_t* dst = isq ? (e.o0 + n0g) : (e.o1 + (size_t)((n0g - 1024) >> 6) * S * 64);
      const int ldd = isq ? 1024 : 64;
#pragma unroll
      for (int m = 0; m < MT; ++m) {
        const int row = rb + m * 16;
        const float pf = (float)e.pos[row];
        float v0[4];
        v0[0] = acc[m][0][0] + bv[0].x; v0[1] = acc[m][0][1] + bv[0].y; v0[2] = acc[m][0][2] + bv[0].z; v0[3] = acc[m][0][3] + bv[0].w;
#pragma unroll
        for (int j = 0; j < 4; ++j) {
          const float pv = shx(v0[j], 32, lane);
          float sn, cs;
          fast_sincos(pf * inv[j], sn, cs);
          v0[j] = (fq_e < 2) ? (v0[j] * cs - pv * sn) : (v0[j] * cs + pv * sn);
        }
        bf16_t* dp = dst + (size_t)row * ldd + cq;
        *(uint2*)(dp) = pack4(v0[0] * qs, v0[1] * qs, v0[2] * qs, v0[3] * qs);
#pragma unroll
        for (int n = 1; n < 4; ++n)
          *(uint2*)(dp + n * 16) = pack4((acc[m][n][0] + bv[n].x) * qs, (acc[m][n][1] + bv[n].y) * qs, (acc[m][n][2] + bv[n].z) * qs, (acc[m][n][3] + bv[n].w) * qs);
      }
    }
  } else {
    const int rb = m0 + wr * (MT * 16) + fq_e * 4;
    const int rbp = m0 + wr * (MT * 16) + ((((fq_e & 1) << 1) | (fq_e >> 1)) * 4);
    if constexpr (EPI == E_V) {
      const int hd = n0g >> 7, cb = n0g & 127;
#pragma unroll
      for (int m = 0; m < MT; ++m) {
        const float4 r4 = *(const float4*)(e.rinv + rb + m * 16);
#pragma unroll
        for (int n = 0; n < 4; ++n)
          *(uint2*)(e.o2 + ((size_t)hd * 128 + cb + n * 16 + fr_e) * S + rbp + m * 16) = pack4(acc[m][n][0] * r4.x, acc[m][n][1] * r4.y, acc[m][n][2] * r4.z, acc[m][n][3] * r4.w);
      }
    } else if constexpr (EPI == E_SV) {
      const int kvh = n0g >> 6;
#pragma unroll
      for (int n = 0; n < 4; ++n) {
        const float bb = e.bias[1280 + n0g + n * 16 + fr_e];
#pragma unroll
        for (int m = 0; m < MT; ++m)
          *(uint2*)(e.o2 + ((size_t)kvh * 64 + n * 16 + fr_e) * S + rbp + m * 16) = pack4(acc[m][n][0] + bb, acc[m][n][1] + bb, acc[m][n][2] + bb, acc[m][n][3] + bb);
      }
    }
  }
}

template <int DQK, int DV, int KT>
DI void attn_item(const bf16_t* __restrict__ Q, int ldq, const bf16_t* __restrict__ Kp, const bf16_t* __restrict__ Vt,
                  bf16_t* __restrict__ O, int ldo, int q0, int kt_begin, int kt_end, int W, float m_init, float l_init,
                  unsigned char* lds, const int g_wave) {
  constexpr int KSTR = DQK * 2 + 16;
  constexpr int KCPR = DQK / 8;
  constexpr int VSTR = KT * 2 + 16;
  constexpr int VCPR = KT / 8;
  constexpr int KCH = KT * KCPR / NT;
  constexpr int VCH = DV * VCPR / NT;
  constexpr int NKS = DQK / 16, NDV = DV / 32, NKK = KT / 32;
  constexpr int KBUF = KT * KSTR, VBUF = DV * VSTR;
  static_assert(KCH * NT == KT * KCPR && VCH * NT == DV * VCPR, "chunking");
  static_assert(2 * KBUF + 3 * VBUF <= LDS_BYTES, "lds");
  int tid_ = TID;
  asm volatile("" : "+v"(tid_));
  const int tid = tid_, w = tid >> 6, lane = tid & 63, r = lane & 31, h = lane >> 5;
  const int qw0 = q0 + w * 32, qpos = qw0 + r;
  bf16x8 qf[NKS];
#pragma unroll
  for (int ks = 0; ks < NKS; ++ks) qf[ks] = *(const bf16x8*)(Q + (size_t)qpos * ldq + ks * 16 + h * 8);
  f32x16 ot[NDV];
#pragma unroll
  for (int d = 0; d < NDV; ++d)
#pragma unroll
    for (int i = 0; i < 16; ++i) ot[d][i] = 0.f;
  float m = m_init, l = (h == 0) ? l_init : 0.f;
  f32x16 st;
  bf16x8 pbf[2];
  u32x4 kr[KCH], vr[VCH];
#define A_ISSUE(kt) do { const unsigned char* kg = (const unsigned char*)(Kp + (size_t)(kt) * DQK); \
    _Pragma("unroll") for (int j = 0; j < KCH; ++j) kr[j] = *(const u32x4*)(kg + (size_t)(tid + NT * j) * 16); \
    _Pragma("unroll") for (int j = 0; j < VCH; ++j) { const int c = tid + NT * j; vr[j] = *(const u32x4*)(Vt + (size_t)(c / VCPR) * S + (kt) + (c % VCPR) * 8); } __builtin_amdgcn_sched_barrier(0); } while (0)
#define A_WRITE(kbuf, vbuf) do { unsigned char* Kw = lds + (kbuf) * KBUF; unsigned char* Vw = lds + 2 * KBUF + (vbuf) * VBUF; \
    _Pragma("unroll") for (int j = 0; j < KCH; ++j) { const int c = tid + NT * j; *(u32x4*)(Kw + (c / KCPR) * KSTR + (c % KCPR) * 16) = kr[j]; } \
    _Pragma("unroll") for (int j = 0; j < VCH; ++j) { const int c = tid + NT * j; *(u32x4*)(Vw + (c / VCPR) * VSTR + (c % VCPR) * 16) = vr[j]; } } while (0)
#define A_QK(Kh) do { \
    _Pragma("unroll") for (int i = 0; i < 16; ++i) st[i] = 0.f; \
    __builtin_amdgcn_sched_barrier(0); \
    bf16x8 kfr[NKS]; \
    _Pragma("unroll") for (int ks = 0; ks < NKS; ++ks) kfr[ks] = *(const bf16x8*)((Kh) + r * KSTR + ks * 32 + h * 16); \
    _Pragma("unroll") for (int ks = 0; ks < NKS; ++ks) st = MFMA32(kfr[ks], qf[ks], st); \
    __builtin_amdgcn_sched_group_barrier(0x100, 3, 0); \
    _Pragma("unroll") for (int i = 0; i < NKS - 3; ++i) { __builtin_amdgcn_sched_group_barrier(0x008, 1, 0); __builtin_amdgcn_sched_group_barrier(0x100, 1, 0); } \
    __builtin_amdgcn_sched_group_barrier(0x008, 3, 0); \
    __builtin_amdgcn_sched_barrier(0); } while (0)
#define A_MASK(kth) do { \
    const bool need_mask = ((kth) + 31 > qw0) || (qw0 + 31 - (kth) >= W); \
    if (need_mask) { \
      _Pragma("unroll") for (int i = 0; i < 16; ++i) { \
        const int kpos = (kth) + crow(i, h); \
        const bool valid = (kpos <= qpos) && (qpos - kpos < W); \
        st[i] = valid ? st[i] : -INFINITY; } } } while (0)
#define A_SM() \
    float mx = st[0]; \
    _Pragma("unroll") for (int i = 1; i < 16; ++i) mx = fmaxf(mx, st[i]); \
    mx = fmaxf(mx, shx(mx, 32, lane)); \
    const float m_new = fmaxf(m, mx); \
    const float alpha = __builtin_amdgcn_exp2f(m - m_new); \
    m = m_new; \
    float rs = 0.f; \
    _Pragma("unroll") for (int i = 0; i < 16; ++i) { \
      const float pv = __builtin_amdgcn_exp2f(st[i] - m_new); rs += pv; st[i] = pv; } \
    l = l * alpha + rs;
#define A_PV(Vh) do { \
    _Pragma("unroll") for (int s2 = 0; s2 < 2; ++s2) \
    _Pragma("unroll") for (int d = 0; d < NDV; ++d) { \
      const bf16x8 av = *(const bf16x8*)((Vh) + (d * 32 + r) * VSTR + 32 * s2 + h * 16); \
      ot[d] = MFMA32(av, pbf[s2], ot[d]); } } while (0)
#define A_RESCALE_PACK() do { \
    _Pragma("unroll") for (int d = 0; d < NDV; ++d) \
    _Pragma("unroll") for (int i = 0; i < 16; ++i) ot[d][i] *= alpha; \
    _Pragma("unroll") for (int s2 = 0; s2 < 2; ++s2) { \
      u32x4 pu; \
      pu.x = pk_bf16(st[8 * s2 + 0], st[8 * s2 + 1]); pu.y = pk_bf16(st[8 * s2 + 2], st[8 * s2 + 3]); \
      pu.z = pk_bf16(st[8 * s2 + 4], st[8 * s2 + 5]); pu.w = pk_bf16(st[8 * s2 + 6], st[8 * s2 + 7]); \
      pbf[s2] = __builtin_bit_cast(bf16x8, pu); } } while (0)
#define A_NEED(kth) ((kth) <= qw0 + 63 && (qw0 - ((kth) + 31)) < W)
  const int ntile = (kt_end - kt_begin) / KT;
  A_ISSUE(kt_begin);
  A_WRITE(0, 0);
  if (ntile > 1) A_ISSUE(kt_begin + KT);
  __syncthreads();
  { u32x4 z4 = {0u, 0u, 0u, 0u}; pbf[0] = __builtin_bit_cast(bf16x8, z4); pbf[1] = pbf[0]; }
  const unsigned char* Vp = lds + 2 * KBUF;
  for (int t = 0; t < ntile; ++t) {
    const int kt = kt_begin + t * KT;
    const int kcur = t & 1, vcur = t % 3;
    if (t + 1 < ntile) A_WRITE(kcur ^ 1, (t + 1) % 3);
    if (t + 2 < ntile) A_ISSUE(kt + 2 * KT);
    const unsigned char* Kl = lds + kcur * KBUF;
    const unsigned char* Vl = lds + 2 * KBUF + vcur * VBUF;
#pragma unroll 1
    for (int hh = 0; hh < NKK; ++hh) {
      const int kth = kt + 32 * hh;
      if (A_NEED(kth)) {
        A_QK(Kl + hh * 32 * KSTR);
        A_MASK(kth);
        __builtin_amdgcn_sched_barrier(0);
        A_SM();
        A_PV(Vp);
        __builtin_amdgcn_sched_group_barrier(0x100, 2, 0);
#pragma unroll
        for (int i = 0; i < 2 * NDV - 2; ++i) {
          __builtin_amdgcn_sched_group_barrier(0x008, 1, 0);
          __builtin_amdgcn_sched_group_barrier(0x100, 1, 0);
          __builtin_amdgcn_sched_group_barrier(0x002, 10, 0);
        }
        __builtin_amdgcn_sched_group_barrier(0x008, 2, 0);
        __builtin_amdgcn_sched_barrier(0);
        A_RESCALE_PACK();
        Vp = Vl + hh * 64;
      }
    }
    __syncthreads();
  }
  A_PV(Vp);
  __syncthreads();
#undef A_ISSUE
#undef A_WRITE
#undef A_QK
#undef A_MASK
#undef A_SM
#undef A_PV
#undef A_RESCALE_PACK
#undef A_NEED
  const float lt = l + shx(l, 32, lane);
  const float il = 1.0f / lt;
#pragma unroll
  for (int d = 0; d < NDV; ++d)
#pragma unroll
    for (int g = 0; g < 4; ++g) {
      uint2 u;
      u.x = pk_bf16(ot[d][4 * g] * il, ot[d][4 * g + 1] * il);
      u.y = pk_bf16(ot[d][4 * g + 2] * il, ot[d][4 * g + 3] * il);
      *(uint2*)(O + (size_t)qpos * ldo + d * 32 + 8 * g + 4 * h) = u;
    }
}

DI void rinv_phase(const bf16_t* __restrict__ lat, float* __restrict__ rq, float* __restrict__ rkv, const int* __restrict__ pos, bf16_t* __restrict__ Kb, const int g_wave) {
  int tid_ = TID;
  asm volatile("" : "+v"(tid_));
  const int tid = tid_, w = tid >> 6, lane = tid & 63;
  const int rstride = gridDim.x * 8;
  const float inv = exp2f(-(float)(lane & 31) * (1.0f / 32.0f) * LOG2THETA);
  for (int row0 = blockIdx.x * 8 + w; row0 < S; row0 += rstride * 4) {
    u32x4 uq[4], uk[4];
    unsigned short xa[4], xb[4];
    int ps[4];
#pragma unroll
    for (int rr = 0; rr < 4; ++rr) {
      const int row = row0 + rr * rstride;
      uq[rr] = u32x4{0u, 0u, 0u, 0u}; uk[rr] = u32x4{0u, 0u, 0u, 0u}; xa[rr] = 0; xb[rr] = 0; ps[rr] = 0;
      if (row < S) {
        const bf16_t* pr = lat + (size_t)row * 768;
        if (lane < 48) uq[rr] = *(const u32x4*)(pr + lane * 8);
        if (lane < 32) { uk[rr] = *(const u32x4*)(pr + 384 + lane * 8); xa[rr] = pr[640 + lane]; xb[rr] = pr[672 + lane]; ps[rr] = pos[row]; }
      }
    }
#pragma unroll
    for (int rr = 0; rr < 4; ++rr) {
      const int row = row0 + rr * rstride;
      if (row < S) {
        float s1 = 0.f, s2 = 0.f, f;
        { const u32x4 u = uq[rr];
          f = bf_lo(u.x); s1 += f * f; f = bf_hi(u.x); s1 += f * f; f = bf_lo(u.y); s1 += f * f; f = bf_hi(u.y); s1 += f * f;
          f = bf_lo(u.z); s1 += f * f; f = bf_hi(u.z); s1 += f * f; f = bf_lo(u.w); s1 += f * f; f = bf_hi(u.w); s1 += f * f; }
        { const u32x4 u = uk[rr];
          f = bf_lo(u.x); s2 += f * f; f = bf_hi(u.x); s2 += f * f; f = bf_lo(u.y); s2 += f * f; f = bf_hi(u.y); s2 += f * f;
          f = bf_lo(u.z); s2 += f * f; f = bf_hi(u.z); s2 += f * f; f = bf_lo(u.w); s2 += f * f; f = bf_hi(u.w); s2 += f * f; }
#pragma unroll
        for (int o = 32; o >= 1; o >>= 1) { s1 += shx(s1, o, lane); s2 += shx(s2, o, lane); }
        if (lane == 0) { rq[row] = rsqrtf(s1 * (1.0f / 384.0f) + 1e-6f); rkv[row] = rsqrtf(s2 * (1.0f / 256.0f) + 1e-6f); }
        if (lane < 32) {
          const float x1 = bf_lo((unsigned)xa[rr]), x2 = bf_lo((unsigned)xb[rr]);
          float sn, cs;
          fast_sincos((float)ps[rr] * inv, sn, cs);
          const bf16_t y1 = f2bf(x1 * cs - x2 * sn), y2 = f2bf(x2 * cs + x1 * sn);
          bf16_t* kp = Kb + (size_t)row * 192 + 128 + lane;
#pragma unroll
          for (int hd = 0; hd < 8; ++hd) { kp[0] = y1; kp[32] = y2; kp += (size_t)S * 192; }
        }
      }
    }
  }
}

template <bool DO_LN>
DI void rowwise_phase(const float* __restrict__ src, float* __restrict__ dstx, bf16_t* __restrict__ dsth,
                      const float* __restrict__ g, const float* __restrict__ b, const float* __restrict__ sh, const float* __restrict__ sc,
                      float* __restrict__ stats, const int g_wave) {
  int tid_ = TID;
  asm volatile("" : "+v"(tid_));
  const int tid = tid_, w = tid >> 6, lane = tid & 63;
  for (int row = blockIdx.x * 8 + w; row < S; row += gridDim.x * 8) {
    float4 v[4];
#pragma unroll
    for (int j = 0; j < 4; ++j) v[j] = *(const float4*)(src + (size_t)row * D + lane * 4 + 256 * j);
    if (!DO_LN && stats && lane == 0) { float2 s2; s2.x = 0.f; s2.y = 1.f; *(float2*)(stats + (size_t)row * 2) = s2; }
    if (DO_LN) {
      float sum = 0.f;
#pragma unroll
      for (int j = 0; j < 4; ++j) sum += v[j].x + v[j].y + v[j].z + v[j].w;
#pragma unroll
      for (int o = 32; o >= 1; o >>= 1) sum += shx(sum, o, lane);
      const float mean = sum * (1.0f / D);
      float sq = 0.f;
#pragma unroll
      for (int j = 0; j < 4; ++j) {
        v[j].x -= mean; v[j].y -= mean; v[j].z -= mean; v[j].w -= mean;
        sq += v[j].x * v[j].x + v[j].y * v[j].y + v[j].z * v[j].z + v[j].w * v[j].w;
      }
#pragma unroll
      for (int o = 32; o >= 1; o >>= 1) sq += shx(sq, o, lane);
      const float rstd = rsqrtf(sq * (1.0f / D) + 1e-5f);
      if (stats && lane == 0) { float2 s2; s2.x = mean; s2.y = rstd; *(float2*)(stats + (size_t)row * 2) = s2; }
#pragma unroll
      for (int j = 0; j < 4; ++j) {
        const float4 gg = *(const float4*)(g + lane * 4 + 256 * j);
        const float4 bb = *(const float4*)(b + lane * 4 + 256 * j);
        v[j].x = v[j].x * rstd * gg.x + bb.x; v[j].y = v[j].y * rstd * gg.y + bb.y;
        v[j].z = v[j].z * rstd * gg.z + bb.z; v[j].w = v[j].w * rstd * gg.w + bb.w;
      }
    }
    if (dstx) {
#pragma unroll
      for (int j = 0; j < 4; ++j) *(float4*)(dstx + (size_t)row * D + lane * 4 + 256 * j) = v[j];
    }
    if (dsth) {
#pragma unroll
      for (int j = 0; j < 4; ++j) {
        const float4 s1 = *(const float4*)(sc + lane * 4 + 256 * j);
        const float4 s0 = *(const float4*)(sh + lane * 4 + 256 * j);
        uint2 u;
        u.x = pk_bf16(v[j].x * (1.f + s1.x) + s0.x, v[j].y * (1.f + s1.y) + s0.y);
        u.y = pk_bf16(v[j].z * (1.f + s1.z) + s0.z, v[j].w * (1.f + s1.w) + s0.w);
        *(uint2*)(dsth + (size_t)row * D + lane * 4 + 256 * j) = u;
      }
    }
  }
}

struct Job { const float* src; const float* scale; bf16_t* dst; int K, N, mode; };
DI Job get_job(const Params& p, int j) {
  bf16_t* wb = (bf16_t*)(p.ws + WS_W);
  Job jb; jb.scale = nullptr; jb.mode = 0;
  if (j < 12) {
    const int l = j / 3, kind = j % 3;
    if (kind == 0) { jb.src = p.ffn_w_gate + (size_t)l * D * F; jb.dst = wb + l * FFN_L; jb.K = D; jb.N = F; jb.mode = 1; }
    else if (kind == 1) { jb.src = p.ffn_w_up + (size_t)l * D * F; jb.dst = wb + l * FFN_L; jb.K = D; jb.N = F; jb.mode = 2; }
    else { jb.src = p.ffn_w_down + (size_t)l * F * D; jb.dst = wb + l * FFN_L + W_DN_OFF; jb.K = F; jb.N = D; }
  } else if (j < 20) {
    const int jj = (j - 12) >> 2, kind = (j - 12) & 3;
    bf16_t* base = wb + MLA_BASE + jj * MLA_L;
    if (kind == 0) { jb.src = p.mla_w_in + (size_t)jj * D * 704; jb.dst = base; jb.K = D; jb.N = 704; }
    else if (kind == 1) { jb.src = p.mla_w_q_b + (size_t)jj * 384 * 1536; jb.dst = base + W_QB_OFF; jb.K = 384; jb.N = 1536; jb.scale = p.mla_q_norm + jj * 384; }
    else if (kind == 2) { jb.src = p.mla_w_kv_b + (size_t)jj * 256 * 2048; jb.dst = base + W_KVB_OFF; jb.K = 256; jb.N = 2048; jb.scale = p.mla_kv_norm + jj * 256; jb.mode = 3; }
    else { jb.src = p.mla_w_o + (size_t)jj * D * D; jb.dst = base + W_MO_OFF; jb.K = D; jb.N = D; }
  } else {
    const int jj = (j - 20) >> 1, kind = (j - 20) & 1;
    bf16_t* base = wb + SWA_BASE + jj * SWA_L;
    if (kind == 0) { jb.src = p.swa_w_qkv + (size_t)jj * D * 1536; jb.dst = base; jb.K = D; jb.N = 1536; }
    else { jb.src = p.swa_w_o + (size_t)jj * D * D; jb.dst = base + W_SO_OFF; jb.K = D; jb.N = D; }
  }
  return jb;
}
DI int job_tiles(int j) {
  if (j < 12) return 704;
  if (j < 20) { const int kind = (j - 12) & 3; return kind == 0 ? 176 : (kind == 1 ? 144 : (kind == 2 ? 128 : 256)); }
  return ((j - 20) & 1) ? 256 : 384;
}
constexpr int N_TR_TILES = 12 * 704 + 2 * 704 + 2 * 640;
constexpr int N_GEMV = 96;

DI void phase0(const Params& p, unsigned char* lds, const int g_wave) {
  const int tid = TID;
  if (blockIdx.x < N_GEMV) {
    float* red = (float*)lds;
    const int it = blockIdx.x;
    const int l = it / 24, cb = it % 24;
    const int w = tid >> 6, lane = tid & 63;
    const float* wp = p.ada_w + (size_t)l * D * 6144 + cb * 256 + lane * 4;
    float4 a = {0.f, 0.f, 0.f, 0.f};
#pragma unroll 8
    for (int k = w * 128; k < w * 128 + 128; ++k) {
      const float cv = p.c[k];
      const float sv = cv / (1.f + __expf(-cv));
      const float4 wv = *(const float4*)(wp + (size_t)k * 6144);
      a.x += sv * wv.x; a.y += sv * wv.y; a.z += sv * wv.z; a.w += sv * wv.w;
    }
    *(float4*)(red + w * 256 + lane * 4) = a;
    __syncthreads();
    if (tid < 256) {
      float v = p.ada_b[l * 6144 + cb * 256 + tid];
#pragma unroll
      for (int q = 0; q < 8; ++q) v += red[q * 256 + tid];
      ((float*)(p.ws + WS_MOD))[l * 6144 + cb * 256 + tid] = v;
    }
    __syncthreads();
  }
  {
    const int half = tid >> 8, t2 = tid & 255;
    float* tile = (float*)(lds + half * 16640);
    const int kr0 = t2 >> 4, nc = (t2 & 15) * 4;
    Job jb; int k0 = 0, n0 = 0;
    f32x4 vq[4];
    int it = blockIdx.x;
    bool have = it < N_TR_TILES / 2;
    if (have) {
      int t = it * 2 + half, j = 0;
      for (;;) { const int nt = job_tiles(j); if (t < nt) break; t -= nt; ++j; }
      jb = get_job(p, j);
      const int ntn = jb.N >> 6;
      k0 = (t / ntn) * 64; n0 = (t % ntn) * 64;
#pragma unroll
      for (int i = 0; i < 4; ++i) vq[i] = *(const f32x4*)(jb.src + (size_t)(k0 + kr0 + 16 * i) * jb.N + n0 + nc);
    }
    while (have) {
      const Job jc = jb; const int kc0 = k0, nc0 = n0;
      f32x4 vc[4];
#pragma unroll
      for (int i = 0; i < 4; ++i) vc[i] = vq[i];
      it += gridDim.x;
      have = it < N_TR_TILES / 2;
      if (have) {
        int t = it * 2 + half, j = 0;
        for (;;) { const int nt = job_tiles(j); if (t < nt) break; t -= nt; ++j; }
        jb = get_job(p, j);
        const int ntn = jb.N >> 6;
        k0 = (t / ntn) * 64; n0 = (t % ntn) * 64;
#pragma unroll
        for (int i = 0; i < 4; ++i) vq[i] = *(const f32x4*)(jb.src + (size_t)(k0 + kr0 + 16 * i) * jb.N + n0 + nc);
      }
      __syncthreads();
#pragma unroll
      for (int i = 0; i < 4; ++i) {
        const int kr = kr0 + 16 * i;
        f32x4 v = vc[i];
        if (jc.scale) { const float s = jc.scale[kc0 + kr]; v *= s; }
        tile[kr * 65 + nc] = v[0]; tile[kr * 65 + nc + 1] = v[1]; tile[kr * 65 + nc + 2] = v[2]; tile[kr * 65 + nc + 3] = v[3];
      }
      __syncthreads();
#pragma unroll
      for (int i = 0; i < 2; ++i) {
        const int n = (t2 >> 3) + 32 * i, kc = (t2 & 7) * 8;
        uint4 u;
        u.x = pk_bf16(tile[(kc + 0) * 65 + n], tile[(kc + 1) * 65 + n]);
        u.y = pk_bf16(tile[(kc + 2) * 65 + n], tile[(kc + 3) * 65 + n]);
        u.z = pk_bf16(tile[(kc + 4) * 65 + n], tile[(kc + 5) * 65 + n]);
        u.w = pk_bf16(tile[(kc + 6) * 65 + n], tile[(kc + 7) * 65 + n]);
        const int ng = nc0 + n;
        int R = ng;
        if (jc.mode == 1) R = 64 * (ng >> 5) + (ng & 31);
        else if (jc.mode == 2) R = 64 * (ng >> 5) + 32 + (ng & 31);
        else if (jc.mode == 3) R = ((ng & 128) ? 1024 : 0) + (ng >> 8) * 128 + (ng & 127);
        *(uint4*)(jc.dst + (size_t)R * jc.K + kc0 + kc) = u;
      }
    }
  }
  if (blockIdx.x == gridDim.x - 1) {
    float* idv = (float*)(p.ws + WS_ID);
    for (int i = tid; i < D; i += NT) { idv[i] = 1.0f; idv[D + i] = 0.0f; }
  }
  {
    bf16_t* wb = (bf16_t*)(p.ws + WS_W);
    const uint4 z = {0u, 0u, 0u, 0u};
    for (int i = blockIdx.x * NT + tid; i < 2 * 8192; i += gridDim.x * NT) {
      const int jj = i >> 13, o = i & 8191;
      *(uint4*)(wb + MLA_BASE + jj * MLA_L + (size_t)704 * D + (size_t)o * 8) = z;
    }
  }
}

#define XB_TMO      128
#define XB_XCNT(j)  (256  + 64 * (j))
#define XB_XSUB(j)  (1280 + 64 * (j))
#define XB_XGEN(j)  (2304 + 64 * (j))
#define XB_TOP      3328
#define XB_TOPGEN   3392
#define XCD_BAR_WORDS 3456
#define XB_SPIN_CAP (1u << 18)
#define LAS __attribute__((address_space(3)))
DI unsigned xb_ld(unsigned* p) { return __hip_atomic_load(p, __ATOMIC_RELAXED, __HIP_MEMORY_SCOPE_AGENT); }
DI unsigned xb_add(unsigned* p, unsigned v) { return __hip_atomic_fetch_add(p, v, __ATOMIC_RELAXED, __HIP_MEMORY_SCOPE_AGENT); }
DI unsigned xb_xcc_id() { return (unsigned)__builtin_amdgcn_s_getreg((3 << 11) | 20) & 0xFu; }
#define XB_SPIN(cond, bar) do { unsigned _sp = 0; while (cond) { __builtin_amdgcn_s_sleep(1); \
    if ((++_sp & 255u) == 0u) { if (xb_ld(&(bar)[XB_TMO])) break; if (_sp > XB_SPIN_CAP) { atomicAdd(&(bar)[XB_TMO], 1u); break; } } } } while (0)
struct XcdBarrier { unsigned* bar; unsigned x; volatile LAS unsigned* st; };
DI XcdBarrier xcd_barrier_post(unsigned* bar, volatile LAS unsigned* st) {
  XcdBarrier b; b.bar = bar; b.x = xb_xcc_id(); b.st = st;
  if (threadIdx.x == 0) (void)xb_add(&bar[XB_XCNT(b.x)], 1u);
  return b;
}
DI void xcd_barrier_complete(unsigned* bar, unsigned x, unsigned& nloc, unsigned& nx) {
  const unsigned G = gridDim.x * gridDim.y * gridDim.z;
  unsigned sum, cnt, mine, sp = 0u;
  for (;;) {
    sum = 0u; cnt = 0u; mine = 0u;
#pragma unroll
    for (unsigned j = 0; j < 16; ++j) { const unsigned c = xb_ld(&bar[XB_XCNT(j)]); sum += c; cnt += (c > 0u) ? 1u : 0u; mine = (j == x) ? c : mine; }
    if (sum == G) break;
    __builtin_amdgcn_s_sleep(1);
    if ((++sp & 255u) == 0u) { if (xb_ld(&bar[XB_TMO])) break; if (sp > XB_SPIN_CAP) { atomicAdd(&bar[XB_TMO], 1u); break; } }
  }
  nloc = mine > 0u ? mine : 1u; nx = cnt > 0u ? cnt : 1u;
}
DI void xcd_barrier(const XcdBarrier& b, const int g_wave) {
  asm volatile("s_waitcnt vmcnt(0)" ::: "memory");
  __syncthreads();
  if (TID == 0) {
    size_t bz = 0; unsigned bx = b.x;
    asm volatile("" : "+s"(bz), "+s"(bx));
    unsigned* bar = b.bar + bz;
    __builtin_amdgcn_s_waitcnt(0);
    unsigned nloc = b.st[0], nx = b.st[1];
    if (nloc == 0u) { xcd_barrier_complete(bar, bx, nloc, nx); b.st[0] = nloc; b.st[1] = nx; }
    const unsigned old = xb_add(&bar[XB_XSUB(bx)], 1u);
    const unsigned gen = old / nloc;
    if (old + 1u == (gen + 1u) * nloc) {
      __builtin_amdgcn_fence(__ATOMIC_RELEASE, "agent");
      asm volatile("s_waitcnt vmcnt(0)" ::: "memory");
      const unsigned og = xb_add(&bar[XB_TOP], 1u);
      const unsigned tg = og / nx;
      if (og + 1u == (tg + 1u) * nx) xb_add(&bar[XB_TOPGEN], 1u);
      else XB_SPIN(xb_ld(&bar[XB_TOPGEN]) == tg, bar);
      __builtin_amdgcn_fence(__ATOMIC_ACQUIRE, "agent");
      xb_add(&bar[XB_XGEN(bx)], 1u);
      asm volatile("s_waitcnt vmcnt(0)" ::: "memory");
    } else {
      XB_SPIN(xb_ld(&bar[XB_XGEN(bx)]) == gen, bar);
      __builtin_amdgcn_fence(__ATOMIC_ACQUIRE, "agent");
      asm volatile("s_waitcnt vmcnt(0)" ::: "memory");
    }
  }
  __syncthreads();
}

__global__ void __launch_bounds__(NT) fwd_megakernel(Params p) {
  extern __shared__ __attribute__((aligned(1024))) unsigned char lds[];
  cg::grid_group grid = cg::this_grid();
  const int g_wave = __builtin_amdgcn_readfirstlane((int)(threadIdx.x >> 6));
  __shared__ uint4 xb_words;
  if (threadIdx.x == 0) xb_words = make_uint4(0u, 0u, 0u, 0u);
  __syncthreads();
  XcdBarrier xb = xcd_barrier_post((unsigned*)(p.ws + WS_BAR), (volatile LAS unsigned*)&xb_words);
  if (p.out == nullptr) grid.sync();
  const int G = gridDim.x, bid = blockIdx.x;
#define WSL size_t wz_ = 0; asm volatile("" : "+s"(wz_)); unsigned char* ws_ = p.ws + wz_;
#define P_WB ((bf16_t*)(ws_ + WS_W))
#define P_MOD ((float*)(ws_ + WS_MOD))
#define P_RINV ((float*)(ws_ + WS_RINV))
#define P_XZ ((float*)(ws_ + WS_XZ))
#define P_HB ((bf16_t*)(ws_ + WS_H))
#define P_LAT ((bf16_t*)(ws_ + WS_U + U_LAT))
#define P_Q ((bf16_t*)(ws_ + WS_U + U_Q))
#define P_K ((bf16_t*)(ws_ + WS_U + U_K))
#define P_VT ((bf16_t*)(ws_ + WS_U + U_VT))
#define P_O ((bf16_t*)(ws_ + WS_U + U_O))
#define P_ACT ((bf16_t*)(ws_ + WS_U + U_ACT))
#define P_STATS ((float*)(ws_ + WS_STATS))
#define P_ID ((const float*)(ws_ + WS_ID))

  phase0(p, lds, g_wave);
  xcd_barrier(xb, g_wave);
  { WSL; rowwise_phase<false>(p.x, nullptr, P_HB, nullptr, nullptr, P_MOD + 0, P_MOD + 1024, P_STATS, g_wave); }
  xcd_barrier(xb, g_wave);

#pragma unroll 1
  for (int li = 0; li < DEPTH; ++li) {
    const int jj = li >> 1;
    if ((li & 1) == 0) {
      {
        WSL; const bf16_t* w_in = P_WB + MLA_BASE + jj * MLA_L;
        EpiArgs e{}; e.o0 = P_LAT; e.o1 = P_K; e.pos = p.pos;
        for (int L = bid; L < 64 * 3; L += G) { int pm, pn; tile_map(L, 64, 3, pm, pn); gemm_tile<E_LAT>(P_HB, D, w_in, D, D, pm * 256, pn * 256, lds, e, g_wave); }
      }
      xcd_barrier(xb, g_wave);
      { WSL; rinv_phase(P_LAT, P_RINV, P_RINV + S, p.pos, P_K, g_wave); }
      xcd_barrier(xb, g_wave);
      {
        WSL; const bf16_t* w_in = P_WB + MLA_BASE + jj * MLA_L;
        EpiArgs e{}; e.o0 = P_Q; e.o1 = P_K; e.o2 = P_VT; e.pos = p.pos;
        for (int L = bid; L < 64 * 14; L += G) {
          int pm, pn; tile_map(L, 64, 14, pm, pn);
          if (pn < 6) { e.rinv = P_RINV; gemm_tile<E_Q>(P_LAT, 768, w_in + W_QB_OFF, 384, 384, pm * 256, pn * 256, lds, e, g_wave); }
          else if (pn < 10) { e.rinv = P_RINV + S; gemm_tile<E_KN>(P_LAT + 384, 768, w_in + W_KVB_OFF, 256, 256, pm * 256, (pn - 6) * 256, lds, e, g_wave); }
          else { e.rinv = P_RINV + S; gemm_tile<E_V>(P_LAT + 384, 768, w_in + W_KVB_OFF + 1024 * 256, 256, 256, pm * 256, (pn - 10) * 256, lds, e, g_wave); }
        }
      }
      xcd_barrier(xb, g_wave);
      {
        WSL;
        const int nround = (512 + G - 1) / G;
        for (int rep_ = 0; rep_ < R_ATT; ++rep_)
        for (int rr = 0; rr < nround; ++rr) {
          const int j = (rr & 1) ? ((rr + 1) * G - 1 - bid) : (rr * G + bid);
          if (j < 512) {
            const int qblk = 63 - (j >> 3), hd = j & 7;
            attn_item<192, 128, 64>(P_Q + hd * 192, 1536, P_K + (size_t)hd * S * 192, P_VT + (size_t)hd * 128 * S, P_O + hd * 128, 1024,
                                    qblk * 256, 0, qblk * 256 + 256, 1 << 30, -1e30f, 0.f, lds, g_wave);
          }
        }
      }
      xcd_barrier(xb, g_wave);
      {
        WSL; const bf16_t* w_in = P_WB + MLA_BASE + jj * MLA_L;
        EpiArgs e{}; e.xz = P_XZ; e.xsrc = (li == 0) ? p.x : P_XZ; e.gate = P_MOD + li * 6144 + 2048; e.bias = nullptr;
        e.stats = P_STATS; e.lng = (li == 0) ? P_ID : (p.ln_ffn_g + (li - 1) * D); e.lnb = (li == 0) ? (P_ID + D) : (p.ln_ffn_b + (li - 1) * D);
        for (int L = bid; L < 64 * 4; L += G) { int pm, pn; tile_map(L, 64, 4, pm, pn); gemm_tile<E_RES>(P_O, D, w_in + W_MO_OFF, D, D, pm * 256, pn * 256, lds, e, g_wave); }
      }
      xcd_barrier(xb, g_wave);
    } else {
      {
        WSL; const bf16_t* w_qkv = P_WB + SWA_BASE + jj * SWA_L;
        EpiArgs e{}; e.o0 = P_Q; e.o1 = P_K; e.o2 = P_VT; e.pos = p.pos; e.bias = p.swa_b_qkv + jj * 1536;
        const int nfull = (64 * 6 / G) * G, nrem = 64 * 6 - nfull;
        for (int L = bid; L < nfull; L += G) {
          int pm, pn; tile_map(L, 64, 6, pm, pn);
          if (pn < 5) gemm_tile<E_QK>(P_HB, D, w_qkv, D, D, pm * 256, pn * 256, lds, e, g_wave);
          else gemm_tile<E_SV>(P_HB, D, w_qkv + 1280 * D, D, D, pm * 256, 0, lds, e, g_wave);
        }
        for (int ix = bid; ix < 2 * nrem; ix += G) {
          int pm, pn; tile_map(nfull + (ix >> 1), 64, 6, pm, pn);
          const int m0h = pm * 256 + (ix & 1) * 128;
          if (pn < 5) gemm_tile<E_QK, 4>(P_HB, D, w_qkv, D, D, m0h, pn * 256, lds, e, g_wave);
          else gemm_tile<E_SV, 4>(P_HB, D, w_qkv + 1280 * D, D, D, m0h, 0, lds, e, g_wave);
        }
      }
      xcd_barrier(xb, g_wave);
      {
        WSL;
        for (int it = bid; it < 1024; it += G) {
          const int hq = it & 15, qblk = it >> 4, kvh = hq >> 2;
          const int kb0 = qblk > 0 ? qblk * 256 - 128 : 0;
          attn_item<64, 64, 64>(P_Q + hq * 64, 1024, P_K + (size_t)kvh * S * 64, P_VT + (size_t)kvh * 64 * S, P_O + hq * 64, 1024,
                                qblk * 256, kb0, qblk * 256 + 256, 128, p.swa_sinks[jj * 16 + hq] * LOG2E, 1.0f, lds, g_wave);
        }
      }
      xcd_barrier(xb, g_wave);
      {
        WSL; const bf16_t* w_qkv = P_WB + SWA_BASE + jj * SWA_L;
        EpiArgs e{}; e.xz = P_XZ; e.xsrc = P_XZ; e.gate = P_MOD + li * 6144 + 2048; e.bias = p.swa_b_o + jj * D;
        e.stats = P_STATS; e.lng = p.ln_ffn_g + (li - 1) * D; e.lnb = p.ln_ffn_b + (li - 1) * D;
        for (int L = bid; L < 64 * 4; L += G) { int pm, pn; tile_map(L, 64, 4, pm, pn); gemm_tile<E_RES>(P_O, D, w_qkv + W_SO_OFF, D, D, pm * 256, pn * 256, lds, e, g_wave); }
      }
      xcd_barrier(xb, g_wave);
    }
    { WSL; const float* md = P_MOD + li * 6144; rowwise_phase<true>(P_XZ, nullptr, P_HB, p.ln_mix_g + li * D, p.ln_mix_b + li * D, md + 3072, md + 4096, P_STATS, g_wave); }
    xcd_barrier(xb, g_wave);
    {
      WSL; EpiArgs e{}; e.o0 = P_ACT;
      const bf16_t* wgu = P_WB + li * FFN_L;
      const int nfull = (64 * 22 / G) * G, nrem = 64 * 22 - nfull;
      {
        bool pre = false;
        for (int L = bid; L < nfull; L += G) {
          int pm, pn, qm = -1, qn = 0;
          tile_map(L, 64, 22, pm, pn);
          if (L + G < nfull) { tile_map(L + G, 64, 22, qm, qn); qm *= 256; qn *= 256; }
          gemm_tile<E_SWIGLU>(P_HB, D, wgu, D, D, pm * 256, pn * 256, lds, e, g_wave, pre, qm, qn);
          pre = (qm >= 0);
        }
      }
      for (int ix = bid; ix < 2 * nrem; ix += G) { int pm, pn; tile_map(nfull + (ix >> 1), 64, 22, pm, pn); gemm_tile<E_SWIGLU, 4>(P_HB, D, wgu, D, D, pm * 256 + (ix & 1) * 128, pn * 256, lds, e, g_wave); }
    }
    xcd_barrier(xb, g_wave);
    {
      WSL; EpiArgs e{}; e.xz = P_XZ; e.xsrc = P_XZ; e.gate = P_MOD + li * 6144 + 5120; e.bias = nullptr;
      e.stats = P_STATS; e.lng = p.ln_mix_g + li * D; e.lnb = p.ln_mix_b + li * D;
      const bf16_t* wdn = P_WB + li * FFN_L + W_DN_OFF;
      {
        for (int L = bid; L < 64 * 4; L += G) { int pm, pn; tile_map(L, 64, 4, pm, pn); gemm_tile<E_RES>(P_ACT, F, wdn, F, F, pm * 256, pn * 256, lds, e, g_wave); }
      }
    }
    xcd_barrier(xb, g_wave);
    {
      WSL; const float* md = P_MOD + li * 6144;
      if (li + 1 < DEPTH) rowwise_phase<true>(P_XZ, nullptr, P_HB, p.ln_ffn_g + li * D, p.ln_ffn_b + li * D, md + 6144, md + 6144 + 1024, P_STATS, g_wave);
      else rowwise_phase<true>(P_XZ, p.out, nullptr, p.ln_ffn_g + li * D, p.ln_ffn_b + li * D, nullptr, nullptr, nullptr, g_wave);
    }
    if (li + 1 < DEPTH) xcd_barrier(xb, g_wave);
  }
}

extern "C" void kernel_launch(void* const* d_in, const int* in_sizes, int n_in, void* d_out, int out_size, void* d_ws, size_t ws_size,
                              hipStream_t stream) {
  static int grid_blocks = 0;
  if (grid_blocks == 0) {
    if (n_in != 23 || out_size != S * D || ws_size < WS_END) {
      fprintf(stderr, "kernel_launch: unexpected shapes (n_in %d out %d ws %zu need %zu)\n", n_in, out_size, ws_size, (size_t)WS_END);
      grid_blocks = -1; return;
    }
    int dev = 0, cus = 0, per_cu = 0;
    (void)hipGetDevice(&dev);
    (void)hipDeviceGetAttribute(&cus, hipDeviceAttributeMultiprocessorCount, dev);
    (void)hipFuncSetAttribute((const void*)fwd_megakernel, hipFuncAttributeMaxDynamicSharedMemorySize, LDS_BYTES);
    (void)hipOccupancyMaxActiveBlocksPerMultiprocessor(&per_cu, (const void*)fwd_megakernel, NT, LDS_BYTES);
    if (per_cu < 1) { fprintf(stderr, "kernel_launch: occupancy query returned %d\n", per_cu); per_cu = 1; }
    per_cu = 1;
    grid_blocks = cus * per_cu;
  }
  if (grid_blocks < 0) return;
  Params p{};
  p.x = (const float*)d_in[0]; p.c = (const float*)d_in[1]; p.pos = (const int*)d_in[2];
  p.ada_w = (const float*)d_in[3]; p.ada_b = (const float*)d_in[4];
  p.ln_mix_g = (const float*)d_in[5]; p.ln_mix_b = (const float*)d_in[6]; p.ln_ffn_g = (const float*)d_in[7]; p.ln_ffn_b = (const float*)d_in[8];
  p.ffn_w_gate = (const float*)d_in[9]; p.ffn_w_up = (const float*)d_in[10]; p.ffn_w_down = (const float*)d_in[11];
  p.mla_w_in = (const float*)d_in[12]; p.mla_q_norm = (const float*)d_in[13]; p.mla_w_q_b = (const float*)d_in[14];
  p.mla_kv_norm = (const float*)d_in[15]; p.mla_w_kv_b = (const float*)d_in[16]; p.mla_w_o = (const float*)d_in[17];
  p.swa_w_qkv = (const float*)d_in[18]; p.swa_b_qkv = (const float*)d_in[19]; p.swa_sinks = (const float*)d_in[20];
  p.swa_w_o = (const float*)d_in[21]; p.swa_b_o = (const float*)d_in[22];
  p.out = (float*)d_out; p.ws = (unsigned char*)d_ws;
  (void)hipMemsetAsync((unsigned char*)d_ws + WS_BAR, 0, XCD_BAR_WORDS * 4, stream);
  void* args[] = {&p};
  hipError_t e = hipLaunchCooperativeKernel((const void*)fwd_megakernel, dim3(grid_blocks), dim3(NT), args, LDS_BYTES, stream);
  if (e != hipSuccess) fprintf(stderr, "cooperative launch failed: %s (grid %d)\n", hipGetErrorString(e), grid_blocks);
}
```

```cpp
#include <hip/hip_runtime.h>
#include <hip/hip_cooperative_groups.h>
#include <cstdio>
#include <cstdint>
namespace cg = cooperative_groups;

typedef unsigned short bf16_t;
typedef short bf16x8 __attribute__((ext_vector_type(8)));
typedef short s16x4 __attribute__((ext_vector_type(4)));
typedef float f32x16 __attribute__((ext_vector_type(16)));
typedef __bf16 bf16x2_t __attribute__((ext_vector_type(2)));
typedef float f32x2_t __attribute__((ext_vector_type(2)));
typedef unsigned u32x4 __attribute__((ext_vector_type(4)));
typedef float f32x4 __attribute__((ext_vector_type(4)));

#define DI __device__ __forceinline__
#define LDSP __attribute__((address_space(3)))
#define MFMA32(a, b, c) __builtin_amdgcn_mfma_f32_32x32x16_bf16((a), (b), (c), 0, 0, 0)

#ifndef R_ATT
#define R_ATT 1
#endif
#ifndef R_F1
#define R_F1 1
#endif
#ifndef R_F2
#define R_F2 1
#endif
constexpr int S = 16384, D = 1024, F = 2816, DEPTH = 4;
constexpr int NT = 512;
constexpr int LDS_BYTES = 131072;
constexpr float ALPHA = 1.681792830507429f;
constexpr float LOG2E = 1.4426950408889634f;
constexpr float LOG2THETA = 18.931568569324174f;
constexpr float QS_MLA = 0.07216878364870322f * LOG2E;
constexpr float QS_SWA = 0.125f * LOG2E;

constexpr size_t MiB = 1048576;
constexpr size_t WS_MOD = 4096;
constexpr size_t WS_BAR = 131072;
constexpr size_t WS_RINV = 262144;
constexpr size_t WS_ID = 393216;
constexpr size_t WS_STATS = 524288;
constexpr size_t WS_XZ = 1 * MiB;
constexpr size_t WS_H = WS_XZ + 64 * MiB;
constexpr size_t WS_W = WS_H + 32 * MiB;
constexpr size_t WS_U = WS_W + 88 * MiB;
constexpr size_t WS_END = WS_U + 184 * MiB;
constexpr size_t U_LAT = 0;
constexpr size_t U_Q = 24 * MiB;
constexpr size_t U_K = 72 * MiB;
constexpr size_t U_VT = 120 * MiB;
constexpr size_t U_O = 152 * MiB;
constexpr size_t U_ACT = 0;
constexpr size_t FFN_L = 8650752, W_DN_OFF = 5767168;
constexpr size_t MLA_BASE = 4 * FFN_L, MLA_L = 2949120, W_QB_OFF = 786432, W_KVB_OFF = 1376256, W_MO_OFF = 1900544;
constexpr size_t SWA_BASE = MLA_BASE + 2 * MLA_L, SWA_L = 2621440, W_SO_OFF = 1572864;

struct Params {
  const float* x; const float* c; const int* pos;
  const float* ada_w; const float* ada_b;
  const float* ln_mix_g; const float* ln_mix_b; const float* ln_ffn_g; const float* ln_ffn_b;
  const float* ffn_w_gate; const float* ffn_w_up; const float* ffn_w_down;
  const float* mla_w_in; const float* mla_q_norm; const float* mla_w_q_b; const float* mla_kv_norm; const float* mla_w_kv_b; const float* mla_w_o;
  const float* swa_w_qkv; const float* swa_b_qkv; const float* swa_sinks; const float* swa_w_o; const float* swa_b_o;
  float* out; unsigned char* ws;
};

DI unsigned pk_bf16(float lo, float hi) { f32x2_t v = {lo, hi}; return __builtin_bit_cast(unsigned, __builtin_convertvector(v, bf16x2_t)); }
DI uint2 pack4(float a, float b, float c, float d) { uint2 u; u.x = pk_bf16(a, b); u.y = pk_bf16(c, d); return u; }
DI bf16_t f2bf(float x) { return (bf16_t)(pk_bf16(x, 0.f) & 0xffffu); }
DI int lane_id() { return (int)__builtin_amdgcn_mbcnt_hi(~0u, __builtin_amdgcn_mbcnt_lo(~0u, 0u)); }
#define TID (g_wave * 64 + lane_id())
DI float shx(float v, int m, int lane) { return __int_as_float(__builtin_amdgcn_ds_bpermute((lane ^ m) << 2, __float_as_int(v))); }
DI int crow(int i, int h) { return (i & 3) + 8 * (i >> 2) + 4 * h; }
DI float bf_lo(unsigned u) { return __uint_as_float(u << 16); }
DI float bf_hi(unsigned u) { return __uint_as_float(u & 0xffff0000u); }

DI void fast_sincos(float ang, float& s, float& c) {
  float n = rintf(ang * 0.15915494309189535f);
  float rr = fmaf(-n, 6.28125f, ang);
  rr = fmaf(-n, 1.9353071795864769e-3f, rr);
  s = __sinf(rr); c = __cosf(rr);
}

struct EpiArgs {
  bf16_t* o0; bf16_t* o1; bf16_t* o2;
  float* xz; const float* xsrc; const float* gate; const float* bias;
  const int* pos; const float* rinv;
  const float* stats; const float* lng; const float* lnb;
};
enum { E_LAT = 0, E_Q = 1, E_KN = 2, E_V = 6, E_RES = 3, E_SWIGLU = 4, E_QK = 5, E_SV = 7 };

#define MFMA16(a, b, c) __builtin_amdgcn_mfma_f32_16x16x32_bf16((a), (b), (c), 0, 0, 0)

DI void tile_map(int L, int nM, int nN, int& pm, int& pn) {
  const int nwg = nM * nN, q = nwg >> 3, r = nwg & 7, xcd = L & 7, off = L >> 3;
  const int wgid = (xcd < r ? xcd * (q + 1) : r * (q + 1) + (xcd - r) * q) + off;
  const int nig = 8 * nN, gid = wgid / nig, fm = gid * 8;
  const int gsz = (nM - fm) < 8 ? (nM - fm) : 8;
  pm = fm + ((wgid % nig) % gsz); pn = (wgid % nig) / gsz;
}

template <int EPI, int MT = 8>
DI void gemm_tile(const bf16_t* __restrict__ A, int lda, const bf16_t* __restrict__ Bt, int ldb, int K, int m0, int n0,
                  unsigned char* lds, const EpiArgs& e, const int g_wave, const bool preloaded = false, const int nm0 = -1, const int nn0 = 0) {
  int tid_ = TID;
  asm volatile("" : "+v"(tid_));
  const int tid = tid_, wid = tid >> 6, lane = tid & 63, wr = wid >> 2, wc = wid & 3, fr = lane & 15, fq = lane >> 4;
  constexpr bool SWAP = !(EPI == E_V || EPI == E_SV);
  f32x4 acc[MT][4];
#pragma unroll
  for (int m = 0; m < MT; ++m)
#pragma unroll
    for (int n = 0; n < 4; ++n) { acc[m][n][0] = 0.f; acc[m][n][1] = 0.f; acc[m][n][2] = 0.f; acc[m][n][3] = 0.f; }
  const int sbyte = lane * 16, swz = sbyte ^ (((sbyte >> 9) & 1) << 5);
  const int R0 = (wid >> 1) * 16 + (swz >> 6), C0 = (wid & 1) * 32 + ((swz & 63) >> 1);
  const bf16_t* Ab = A + (size_t)m0 * lda;
  const bf16_t* Bb = Bt + (size_t)n0 * ldb;
  const unsigned aoff = (unsigned)(R0 * lda + C0), boff = (unsigned)(R0 * ldb + C0);
  const int lrd = fr * 64 + ((fq * 16) ^ ((fr >> 3) << 5));
  const int lbase = wid * 1024;
#define G_STAGE(buf, kt) do { _Pragma("unroll") for (int i = 0; i < 4; ++i) { \
    if (i < MT / 2) __builtin_amdgcn_global_load_lds((const unsigned*)(Ab + (aoff + (unsigned)(64 * i * lda) + (unsigned)((kt) * 64))), \
        (LDSP unsigned*)(lds + (buf) * 65536 + lbase + i * 8192), 16, 0, 0); \
    __builtin_amdgcn_global_load_lds((const unsigned*)(Bb + (boff + (unsigned)(64 * i * ldb) + (unsigned)((kt) * 64))), \
        (LDSP unsigned*)(lds + (buf) * 65536 + 32768 + lbase + i * 8192), 16, 0, 0); } __builtin_amdgcn_sched_barrier(0); } while (0)
  const int nt = K >> 6;
  const bool late = __builtin_amdgcn_readfirstlane(tid >> 8) != 0;
  if (!preloaded) {
    G_STAGE(0, 0);
    asm volatile("s_waitcnt vmcnt(0)" ::: "memory");
    __syncthreads();
  }
#define G_KSTEP(ks) do { \
      bf16x8 Bf[4], At[MT]; \
      _Pragma("unroll") for (int n = 0; n < 4; ++n) Bf[n] = *(const bf16x8*)(pb + (n * 2 + (ks)) * 1024); \
      _Pragma("unroll") for (int m = 0; m < MT; ++m) At[m] = *(const bf16x8*)(pa + (m * 2 + (ks)) * 1024); \
      _Pragma("unroll") for (int m = 0; m < MT; ++m) \
      _Pragma("unroll") for (int n = 0; n < 4; ++n) acc[m][n] = SWAP ? MFMA16(Bf[n], At[m], acc[m][n]) : MFMA16(At[m], Bf[n], acc[m][n]); \
      __builtin_amdgcn_sched_group_barrier(0x100, 9, 0); \
      _Pragma("unroll") for (int m = 0; m < MT; ++m) { \
        __builtin_amdgcn_sched_group_barrier(0x008, 4, 0); \
        if (m < MT - 5) __builtin_amdgcn_sched_group_barrier(0x100, 1, 0); } \
      __builtin_amdgcn_sched_barrier(0); } while (0)
  for (int t = 0; t < nt; ++t) {
    const int cur = t & 1;
    const unsigned char* pa = lds + cur * 65536 + wr * (MT * 2048) + lrd;
    const unsigned char* pb = lds + cur * 65536 + 32768 + wc * 8192 + lrd;
    const bool lastk = (t + 1 == nt);
    if (lastk && nm0 >= 0) { Ab = A + (size_t)nm0 * lda; Bb = Bt + (size_t)nn0 * ldb; }
    const bool dost = !lastk || nm0 >= 0;
    const int kst = lastk ? 0 : t + 1;
    if (!late) { if (dost) G_STAGE(cur ^ 1, kst); }
    __builtin_amdgcn_sched_barrier(0);
    __builtin_amdgcn_s_setprio(3);
    G_KSTEP(0);
    __builtin_amdgcn_s_setprio(0);
    if (late) { if (dost) G_STAGE(cur ^ 1, kst); }
    __builtin_amdgcn_sched_barrier(0);
    __builtin_amdgcn_s_setprio(3);
    G_KSTEP(1);
    __builtin_amdgcn_s_setprio(0);
    asm volatile("s_waitcnt vmcnt(0)" ::: "memory");
    __syncthreads();
  }
#undef G_STAGE
#undef G_KSTEP
  int fr_e = lane & 15, fq_e = lane >> 4;
  asm volatile("" : "+v"(fr_e), "+v"(fq_e));
  const int n0g = n0 + wc * 64;
  if constexpr (SWAP) {
    const int rb = m0 + wr * (MT * 16) + fr_e;
    const int cq = fq_e * 4;
    if constexpr (EPI == E_LAT) {
      if (n0g < 704) {
#pragma unroll
        for (int m = 0; m < MT; ++m)
#pragma unroll
          for (int n = 0; n < 4; ++n)
            *(uint2*)(e.o0 + (size_t)(rb + m * 16) * 768 + n0g + n * 16 + cq) = pack4(acc[m][n][0], acc[m][n][1], acc[m][n][2], acc[m][n][3]);
      }
    } else if constexpr (EPI == E_Q) {
      const bool is_rope = (n0g % 192) == 128;
      float inv[2][4];
#pragma unroll
      for (int n = 0; n < 2; ++n)
#pragma unroll
        for (int j = 0; j < 4; ++j) inv[n][j] = exp2f(-(float)(n * 16 + cq + j) * (1.0f / 32.0f) * LOG2THETA);
#pragma unroll
      for (int m = 0; m < MT; ++m) {
        const int row = rb + m * 16;
        const float ri = e.rinv[row] * QS_MLA;
        float v[4][4];
#pragma unroll
        for (int n = 0; n < 4; ++n)
#pragma unroll
          for (int j = 0; j < 4; ++j) v[n][j] = acc[m][n][j] * ri;
        if (is_rope) {
          const float pf = (float)e.pos[row];
#pragma unroll
          for (int n = 0; n < 2; ++n)
#pragma unroll
            for (int j = 0; j < 4; ++j) {
              float sn, cs;
              fast_sincos(pf * inv[n][j], sn, cs);
              const float y0 = v[n][j] * cs - v[n + 2][j] * sn, y1 = v[n + 2][j] * cs + v[n][j] * sn;
              v[n][j] = y0; v[n + 2][j] = y1;
            }
        }
#pragma unroll
        for (int n = 0; n < 4; ++n) *(uint2*)(e.o0 + (size_t)row * 1536 + n0g + n * 16 + cq) = pack4(v[n][0], v[n][1], v[n][2], v[n][3]);
      }
    } else if constexpr (EPI == E_KN) {
      const int hd = n0g >> 7, cb = n0g & 127;
#pragma unroll
      for (int m = 0; m < MT; ++m) {
        const int row = rb + m * 16;
        const float ri = e.rinv[row];
#pragma unroll
        for (int n = 0; n < 4; ++n)
          *(uint2*)(e.o1 + ((size_t)hd * S + row) * 192 + cb + n * 16 + cq) = pack4(acc[m][n][0] * ri, acc[m][n][1] * ri, acc[m][n][2] * ri, acc[m][n][3] * ri);
      }
    } else if constexpr (EPI == E_RES) {
#pragma unroll
      for (int n = 0; n < 4; ++n) {
        const int col = n0g + n * 16 + cq;
        const float4 g4 = *(const float4*)(e.gate + col);
        float4 b4 = {0.f, 0.f, 0.f, 0.f};
        if (e.bias) b4 = *(const float4*)(e.bias + col);
        float4 lg = *(const float4*)(e.lng + col), lb = *(const float4*)(e.lnb + col);
        lg.x *= ALPHA; lg.y *= ALPHA; lg.z *= ALPHA; lg.w *= ALPHA; lb.x *= ALPHA; lb.y *= ALPHA; lb.z *= ALPHA; lb.w *= ALPHA;
#pragma unroll
        for (int m = 0; m < MT; ++m) {
          const size_t idx = (size_t)(rb + m * 16) * D + col;
          const float4 z4 = *(const float4*)(e.xsrc + idx);
          const float2 st2 = *(const float2*)(e.stats + (size_t)(rb + m * 16) * 2);
          float4 o4;
          o4.x = (z4.x - st2.x) * st2.y * lg.x + lb.x + g4.x * (acc[m][n][0] + b4.x); o4.y = (z4.y - st2.x) * st2.y * lg.y + lb.y + g4.y * (acc[m][n][1] + b4.y);
          o4.z = (z4.z - st2.x) * st2.y * lg.z + lb.z + g4.z * (acc[m][n][2] + b4.z); o4.w = (z4.w - st2.x) * st2.y * lg.w + lb.w + g4.w * (acc[m][n][3] + b4.w);
          *(float4*)(e.xz + idx) = o4;
        }
      }
    } else if constexpr (EPI == E_SWIGLU) {
      const int oc = (n0g >> 1) + cq;
#pragma unroll
      for (int m = 0; m < MT; ++m) {
        const int row = rb + m * 16;
#pragma unroll
        for (int n = 0; n < 2; ++n) {
          float a4[4];
#pragma unroll
          for (int j = 0; j < 4; ++j) {
            const float g = acc[m][n][j];
            a4[j] = g * __builtin_amdgcn_rcpf(1.f + __builtin_amdgcn_exp2f(-g * LOG2E)) * acc[m][n + 2][j];
          }
          *(uint2*)(e.o0 + (size_t)row * F + oc + n * 16) = pack4(a4[0], a4[1], a4[2], a4[3]);
        }
      }
    } else if constexpr (EPI == E_QK) {
      float4 bv[4];
#pragma unroll
      for (int n = 0; n < 4; ++n) bv[n] = *(const float4*)(e.bias + n0g + n * 16 + cq);
      float inv[4];
#pragma unroll
      for (int j = 0; j < 4; ++j) inv[j] = exp2f(-(float)(((fq_e & 1) * 4) + j) * 0.125f * LOG2THETA);
      const bool isq = n0g < 1024;
      const float qs = isq ? QS_SWA : 1.0f;
      bf16_t* dst = isq ? (e.o0 + n0g) : (e.o1 + (size_t)((n0g - 1024) >> 6) * S * 64);
      const int ldd = isq ? 1024 : 64;
#pragma unroll
      for (int m = 0; m < MT; ++m) {
        const int row = rb + m * 16;
        const float pf = (float)e.pos[row];
        float v0[4];
        v0[0] = acc[m][0][0] + bv[0].x; v0[1] = acc[m][0][1] + bv[0].y; v0[2] = acc[m][0][2] + bv[0].z; v0[3] = acc[m][0][3] + bv[0].w;
#pragma unroll
        for (int j = 0; j < 4; ++j) {
          const float pv = shx(v0[j], 32, lane);
          float sn, cs;
          fast_sincos(pf * inv[j], sn, cs);
          v0[j] = (fq_e < 2) ? (v0[j] * cs - pv * sn) : (v0[j] * cs + pv * sn);
        }
        bf16_t* dp = dst + (size_t)row * ldd + cq;
        *(uint2*)(dp) = pack4(v0[0] * qs, v0[1] * qs, v0[2] * qs, v0[3] * qs);
#pragma unroll
        for (int n = 1; n < 4; ++n)
          *(uint2*)(dp + n * 16) = pack4((acc[m][n][0] + bv[n].x) * qs, (acc[m][n][1] + bv[n].y) * qs, (acc[m][n][2] + bv[n].z) * qs, (acc[m][n][3] + bv[n].w) * qs);
      }
    }
  } else {
    const int rb = m0 + wr * (MT * 16) + fq_e * 4;
    const int rbp = m0 + wr * (MT * 16) + ((((fq_e & 1) << 1) | (fq_e >> 1)) * 4);
    if constexpr (EPI == E_V) {
      const int hd = n0g >> 7, cb = n0g & 127;
#pragma unroll
      for (int m = 0; m < MT; ++m) {
        const float4 r4 = *(const float4*)(e.rinv + rb + m * 16);
#pragma unroll
        for (int n = 0; n < 4; ++n)
          *(uint2*)(e.o2 + ((size_t)hd * 128 + cb + n * 16 + fr_e) * S + rbp + m * 16) = pack4(acc[m][n][0] * r4.x, acc[m][n][1] * r4.y, acc[m][n][2] * r4.z, acc[m][n][3] * r4.w);
      }
    } else if constexpr (EPI == E_SV) {
      const int kvh = n0g >> 6;
#pragma unroll
      for (int n = 0; n < 4; ++n) {
        const float bb = e.bias[1280 + n0g + n * 16 + fr_e];
#pragma unroll
        for (int m = 0; m < MT; ++m)
          *(uint2*)(e.o2 + ((size_t)kvh * 64 + n * 16 + fr_e) * S + rbp + m * 16) = pack4(acc[m][n][0] + bb, acc[m][n][1] + bb, acc[m][n][2] + bb, acc[m][n][3] + bb);
      }
    }
  }
}

template <int DQK, int DV, int KT>
DI void attn_item(const bf16_t* __restrict__ Q, int ldq, const bf16_t* __restrict__ Kp, const bf16_t* __restrict__ Vt,
                  bf16_t* __restrict__ O, int ldo, int q0, int kt_begin, int kt_end, int W, float m_init, float l_init,
                  unsigned char* lds, const int g_wave) {
  constexpr int KSTR = DQK * 2 + 16;
  constexpr int KCPR = DQK / 8;
  constexpr int VSTR = KT * 2 + 16;
  constexpr int VCPR = KT / 8;
  constexpr int KCH = KT * KCPR / NT;
  constexpr int VCH = DV * VCPR / NT;
  constexpr int NKS = DQK / 16, NDV = DV / 32, NKK = KT / 32;
  constexpr int KBUF = KT * KSTR, VBUF = DV * VSTR;
  static_assert(KCH * NT == KT * KCPR && VCH * NT == DV * VCPR, "chunking");
  static_assert(2 * KBUF + 3 * VBUF <= LDS_BYTES, "lds");
  int tid_ = TID;
  asm volatile("" : "+v"(tid_));
  const int tid = tid_, w = tid >> 6, lane = tid & 63, r = lane & 31, h = lane >> 5;
  const int qw0 = q0 + w * 32, qpos = qw0 + r;
  bf16x8 qf[NKS];
#pragma unroll
  for (int ks = 0; ks < NKS; ++ks) qf[ks] = *(const bf16x8*)(Q + (size_t)qpos * ldq + ks * 16 + h * 8);
  f32x16 ot[NDV];
#pragma unroll
  for (int d = 0; d < NDV; ++d)
#pragma unroll
    for (int i = 0; i < 16; ++i) ot[d][i] = 0.f;
  float m = m_init, l = (h == 0) ? l_init : 0.f;
  f32x16 st;
  bf16x8 pbf[2];
  u32x4 kr[KCH], vr[VCH];
#define A_ISSUE(kt) do { const unsigned char* kg = (const unsigned char*)(Kp + (size_t)(kt) * DQK); \
    _Pragma("unroll") for (int j = 0; j < KCH; ++j) kr[j] = *(const u32x4*)(kg + (size_t)(tid + NT * j) * 16); \
    _Pragma("unroll") for (int j = 0; j < VCH; ++j) { const int c = tid + NT * j; vr[j] = *(const u32x4*)(Vt + (size_t)(c / VCPR) * S + (kt) + (c % VCPR) * 8); } __builtin_amdgcn_sched_barrier(0); } while (0)
#define A_WRITE(kbuf, vbuf) do { unsigned char* Kw = lds + (kbuf) * KBUF; unsigned char* Vw = lds + 2 * KBUF + (vbuf) * VBUF; \
    _Pragma("unroll") for (int j = 0; j < KCH; ++j) { const int c = tid + NT * j; *(u32x4*)(Kw + (c / KCPR) * KSTR + (c % KCPR) * 16) = kr[j]; } \
    _Pragma("unroll") for (int j = 0; j < VCH; ++j) { const int c = tid + NT * j; *(u32x4*)(Vw + (c / VCPR) * VSTR + (c % VCPR) * 16) = vr[j]; } } while (0)
#define A_QK(Kh) do { \
    _Pragma("unroll") for (int i = 0; i < 16; ++i) st[i] = 0.f; \
    __builtin_amdgcn_sched_barrier(0); \
    bf16x8 kfr[NKS]; \
    _Pragma("unroll") for (int ks = 0; ks < NKS; ++ks) kfr[ks] = *(const bf16x8*)((Kh) + r * KSTR + ks * 32 + h * 16); \
    _Pragma("unroll") for (int ks = 0; ks < NKS; ++ks) st = MFMA32(kfr[ks], qf[ks], st); \
    __builtin_amdgcn_sched_group_barrier(0x100, 3, 0); \
    _Pragma("unroll") for (int i = 0; i < NKS - 3; ++i) { __builtin_amdgcn_sched_group_barrier(0x008, 1, 0); __builtin_amdgcn_sched_group_barrier(0x100, 1, 0); } \
    __builtin_amdgcn_sched_group_barrier(0x008, 3, 0); \
    __builtin_amdgcn_sched_barrier(0); } while (0)
#define A_MASK(kth) do { \
    const bool need_mask = ((kth) + 31 > qw0) || (qw0 + 31 - (kth) >= W); \
    if (need_mask) { \
      _Pragma("unroll") for (int i = 0; i < 16; ++i) { \
        const int kpos = (kth) + crow(i, h); \
        const bool valid = (kpos <= qpos) && (qpos - kpos < W); \
        st[i] = valid ? st[i] : -INFINITY; } } } while (0)
#define A_SM() \
    float mx = st[0]; \
    _Pragma("unroll") for (int i = 1; i < 16; ++i) mx = fmaxf(mx, st[i]); \
    mx = fmaxf(mx, shx(mx, 32, lane)); \
    const float m_new = fmaxf(m, mx); \
    const float alpha = __builtin_amdgcn_exp2f(m - m_new); \
    m = m_new; \
    float rs = 0.f; \
    _Pragma("unroll") for (int i = 0; i < 16; ++i) { \
      const float pv = __builtin_amdgcn_exp2f(st[i] - m_new); rs += pv; st[i] = pv; } \
    l = l * alpha + rs;
#define A_PV(Vh) do { \
    _Pragma("unroll") for (int s2 = 0; s2 < 2; ++s2) \
    _Pragma("unroll") for (int d = 0; d < NDV; ++d) { \
      const bf16x8 av = *(const bf16x8*)((Vh) + (d * 32 + r) * VSTR + 32 * s2 + h * 16); \
      ot[d] = MFMA32(av, pbf[s2], ot[d]); } } while (0)
#define A_RESCALE_PACK() do { \
    _Pragma("unroll") for (int d = 0; d < NDV; ++d) \
    _Pragma("unroll") for (int i = 0; i < 16; ++i) ot[d][i] *= alpha; \
    _Pragma("unroll") for (int s2 = 0; s2 < 2; ++s2) { \
      u32x4 pu; \
      pu.x = pk_bf16(st[8 * s2 + 0], st[8 * s2 + 1]); pu.y = pk_bf16(st[8 * s2 + 2], st[8 * s2 + 3]); \
      pu.z = pk_bf16(st[8 * s2 + 4], st[8 * s2 + 5]); pu.w = pk_bf16(st[8 * s2 + 6], st[8 * s2 + 7]); \
      pbf[s2] = __builtin_bit_cast(bf16x8, pu); } } while (0)
#define A_NEED(kth) ((kth) <= qw0 + 63 && (qw0 - ((kth) + 31)) < W)
  const int ntile = (kt_end - kt_begin) / KT;
  A_ISSUE(kt_begin);
  A_WRITE(0, 0);
  if (ntile > 1) A_ISSUE(kt_begin + KT);
  __syncthreads();
  { u32x4 z4 = {0u, 0u, 0u, 0u}; pbf[0] = __builtin_bit_cast(bf16x8, z4); pbf[1] = pbf[0]; }
  const unsigned char* Vp = lds + 2 * KBUF;
  for (int t = 0; t < ntile; ++t) {
    const int kt = kt_begin + t * KT;
    const int kcur = t & 1, vcur = t % 3;
    if (t + 1 < ntile) A_WRITE(kcur ^ 1, (t + 1) % 3);
    if (t + 2 < ntile) A_ISSUE(kt + 2 * KT);
    const unsigned char* Kl = lds + kcur * KBUF;
    const unsigned char* Vl = lds + 2 * KBUF + vcur * VBUF;
#pragma unroll 1
    for (int hh = 0; hh < NKK; ++hh) {
      const int kth = kt + 32 * hh;
      if (A_NEED(kth)) {
        A_QK(Kl + hh * 32 * KSTR);
        A_MASK(kth);
        __builtin_amdgcn_sched_barrier(0);
        A_SM();
        A_PV(Vp);
        __builtin_amdgcn_sched_group_barrier(0x100, 2, 0);
#pragma unroll
        for (int i = 0; i < 2 * NDV - 2; ++i) {
          __builtin_amdgcn_sched_group_barrier(0x008, 1, 0);
          __builtin_amdgcn_sched_group_barrier(0x100, 1, 0);
          __builtin_amdgcn_sched_group_barrier(0x002, 10, 0);
        }
        __builtin_amdgcn_sched_group_barrier(0x008, 2, 0);
        __builtin_amdgcn_sched_barrier(0);
        A_RESCALE_PACK();
        Vp = Vl + hh * 64;
      }
    }
    __syncthreads();
  }
  A_PV(Vp);
  __syncthreads();
#undef A_ISSUE
#undef A_WRITE
#undef A_QK
#undef A_MASK
#undef A_SM
#undef A_PV
#undef A_RESCALE_PACK
#undef A_NEED
  const float lt = l + shx(l, 32, lane);
  const float il = 1.0f / lt;
#pragma unroll
  for (int d = 0; d < NDV; ++d)
#pragma unroll
    for (int g = 0; g < 4; ++g) {
      uint2 u;
      u.x = pk_bf16(ot[d][4 * g] * il, ot[d][4 * g + 1] * il);
      u.y = pk_bf16(ot[d][4 * g + 2] * il, ot[d][4 * g + 3] * il);
      *(uint2*)(O + (size_t)qpos * ldo + d * 32 + 8 * g + 4 * h) = u;
    }
}

DI void rinv_phase(const bf16_t* __restrict__ lat, float* __restrict__ rq, float* __restrict__ rkv, const int* __restrict__ pos, bf16_t* __restrict__ Kb, const int g_wave) {
  int tid_ = TID;
  asm volatile("" : "+v"(tid_));
  const int tid = tid_, w = tid >> 6, lane = tid & 63;
  for (int row = blockIdx.x * 8 + w; row < S; row += gridDim.x * 8) {
    const bf16_t* pr = lat + (size_t)row * 768;
    float s1 = 0.f, s2 = 0.f;
    if (lane < 48) {
      const u32x4 u = *(const u32x4*)(pr + lane * 8);
      float f;
      f = bf_lo(u.x); s1 += f * f; f = bf_hi(u.x); s1 += f * f;
      f = bf_lo(u.y); s1 += f * f; f = bf_hi(u.y); s1 += f * f;
      f = bf_lo(u.z); s1 += f * f; f = bf_hi(u.z); s1 += f * f;
      f = bf_lo(u.w); s1 += f * f; f = bf_hi(u.w); s1 += f * f;
    }
    if (lane < 32) {
      const u32x4 u = *(const u32x4*)(pr + 384 + lane * 8);
      float f;
      f = bf_lo(u.x); s2 += f * f; f = bf_hi(u.x); s2 += f * f;
      f = bf_lo(u.y); s2 += f * f; f = bf_hi(u.y); s2 += f * f;
      f = bf_lo(u.z); s2 += f * f; f = bf_hi(u.z); s2 += f * f;
      f = bf_lo(u.w); s2 += f * f; f = bf_hi(u.w); s2 += f * f;
    }
#pragma unroll
    for (int o = 32; o >= 1; o >>= 1) { s1 += shx(s1, o, lane); s2 += shx(s2, o, lane); }
    if (lane == 0) { rq[row] = rsqrtf(s1 * (1.0f / 384.0f) + 1e-6f); rkv[row] = rsqrtf(s2 * (1.0f / 256.0f) + 1e-6f); }
    if (lane < 32) {
      const float x1 = bf_lo((unsigned)pr[640 + lane]), x2 = bf_lo((unsigned)pr[672 + lane]);
      const float inv = exp2f(-(float)lane * (1.0f / 32.0f) * LOG2THETA);
      float sn, cs;
      fast_sincos((float)pos[row] * inv, sn, cs);
      const bf16_t y1 = f2bf(x1 * cs - x2 * sn), y2 = f2bf(x2 * cs + x1 * sn);
      bf16_t* kp = Kb + (size_t)row * 192 + 128 + lane;
#pragma unroll
      for (int hd = 0; hd < 8; ++hd) { kp[0] = y1; kp[32] = y2; kp += (size_t)S * 192; }
    }
  }
}

template <bool DO_LN>
DI void rowwise_phase(const float* __restrict__ src, float* __restrict__ dstx, bf16_t* __restrict__ dsth,
                      const float* __restrict__ g, const float* __restrict__ b, const float* __restrict__ sh, const float* __restrict__ sc,
                      float* __restrict__ stats, const int g_wave) {
  int tid_ = TID;
  asm volatile("" : "+v"(tid_));
  const int tid = tid_, w = tid >> 6, lane = tid & 63;
  for (int row = blockIdx.x * 8 + w; row < S; row += gridDim.x * 8) {
    float4 v[4];
#pragma unroll
    for (int j = 0; j < 4; ++j) v[j] = *(const float4*)(src + (size_t)row * D + lane * 4 + 256 * j);
    if (!DO_LN && stats && lane == 0) { float2 s2; s2.x = 0.f; s2.y = 1.f; *(float2*)(stats + (size_t)row * 2) = s2; }
    if (DO_LN) {
      float sum = 0.f;
#pragma unroll
      for (int j = 0; j < 4; ++j) sum += v[j].x + v[j].y + v[j].z + v[j].w;
#pragma unroll
      for (int o = 32; o >= 1; o >>= 1) sum += shx(sum, o, lane);
      const float mean = sum * (1.0f / D);
      float sq = 0.f;
#pragma unroll
      for (int j = 0; j < 4; ++j) {
        v[j].x -= mean; v[j].y -= mean; v[j].z -= mean; v[j].w -= mean;
        sq += v[j].x * v[j].x + v[j].y * v[j].y + v[j].z * v[j].z + v[j].w * v[j].w;
      }
#pragma unroll
      for (int o = 32; o >= 1; o >>= 1) sq += shx(sq, o, lane);
      const float rstd = rsqrtf(sq * (1.0f / D) + 1e-5f);
      if (stats && lane == 0) { float2 s2; s2.x = mean; s2.y = rstd; *(float2*)(stats + (size_t)row * 2) = s2; }
#pragma unroll
      for (int j = 0; j < 4; ++j) {
        const float4 gg = *(const float4*)(g + lane * 4 + 256 * j);
        const float4 bb = *(const float4*)(b + lane * 4 + 256 * j);
        v[j].x = v[j].x * rstd * gg.x + bb.x; v[j].y = v[j].y * rstd * gg.y + bb.y;
        v[j].z = v[j].z * rstd * gg.z + bb.z; v[j].w = v[j].w * rstd * gg.w + bb.w;
      }
    }
    if (dstx) {
#pragma unroll
      for (int j = 0; j < 4; ++j) *(float4*)(dstx + (size_t)row * D + lane * 4 + 256 * j) = v[j];
    }
    if (dsth) {
#pragma unroll
      for (int j = 0; j < 4; ++j) {
        const float4 s1 = *(const float4*)(sc + lane * 4 + 256 * j);
        const float4 s0 = *(const float4*)(sh + lane * 4 + 256 * j);
        uint2 u;
        u.x = pk_bf16(v[j].x * (1.f + s1.x) + s0.x, v[j].y * (1.f + s1.y) + s0.y);
        u.y = pk_bf16(v[j].z * (1.f + s1.z) + s0.z, v[j].w * (1.f + s1.w) + s0.w);
        *(uint2*)(dsth + (size_t)row * D + lane * 4 + 256 * j) = u;
      }
    }
  }
}

struct Job { const float* src; const float* scale; bf16_t* dst; int K, N, mode; };
DI Job get_job(const Params& p, int j) {
  bf16_t* wb = (bf16_t*)(p.ws + WS_W);
  Job jb; jb.scale = nullptr; jb.mode = 0;
  if (j < 12) {
    const int l = j / 3, kind = j % 3;
    if (kind == 0) { jb.src = p.ffn_w_gate + (size_t)l * D * F; jb.dst = wb + l * FFN_L; jb.K = D; jb.N = F; jb.mode = 1; }
    else if (kind == 1) { jb.src = p.ffn_w_up + (size_t)l * D * F; jb.dst = wb + l * FFN_L; jb.K = D; jb.N = F; jb.mode = 2; }
    else { jb.src = p.ffn_w_down + (size_t)l * F * D; jb.dst = wb + l * FFN_L + W_DN_OFF; jb.K = F; jb.N = D; }
  } else if (j < 20) {
    const int jj = (j - 12) >> 2, kind = (j - 12) & 3;
    bf16_t* base = wb + MLA_BASE + jj * MLA_L;
    if (kind == 0) { jb.src = p.mla_w_in + (size_t)jj * D * 704; jb.dst = base; jb.K = D; jb.N = 704; }
    else if (kind == 1) { jb.src = p.mla_w_q_b + (size_t)jj * 384 * 1536; jb.dst = base + W_QB_OFF; jb.K = 384; jb.N = 1536; jb.scale = p.mla_q_norm + jj * 384; }
    else if (kind == 2) { jb.src = p.mla_w_kv_b + (size_t)jj * 256 * 2048; jb.dst = base + W_KVB_OFF; jb.K = 256; jb.N = 2048; jb.scale = p.mla_kv_norm + jj * 256; jb.mode = 3; }
    else { jb.src = p.mla_w_o + (size_t)jj * D * D; jb.dst = base + W_MO_OFF; jb.K = D; jb.N = D; }
  } else {
    const int jj = (j - 20) >> 1, kind = (j - 20) & 1;
    bf16_t* base = wb + SWA_BASE + jj * SWA_L;
    if (kind == 0) { jb.src = p.swa_w_qkv + (size_t)jj * D * 1536; jb.dst = base; jb.K = D; jb.N = 1536; }
    else { jb.src = p.swa_w_o + (size_t)jj * D * D; jb.dst = base + W_SO_OFF; jb.K = D; jb.N = D; }
  }
  return jb;
}
DI int job_tiles(int j) {
  if (j < 12) return 704;
  if (j < 20) { const int kind = (j - 12) & 3; return kind == 0 ? 176 : (kind == 1 ? 144 : (kind == 2 ? 128 : 256)); }
  return ((j - 20) & 1) ? 256 : 384;
}
constexpr int N_TR_TILES = 12 * 704 + 2 * 704 + 2 * 640;
constexpr int N_GEMV = 96;

DI void phase0(const Params& p, unsigned char* lds, const int g_wave) {
  const int tid = TID;
  if (blockIdx.x < N_GEMV) {
    float* red = (float*)lds;
    const int it = blockIdx.x;
    const int l = it / 24, cb = it % 24;
    const int w = tid >> 6, lane = tid & 63;
    const float* wp = p.ada_w + (size_t)l * D * 6144 + cb * 256 + lane * 4;
    float4 a = {0.f, 0.f, 0.f, 0.f};
#pragma unroll 8
    for (int k = w * 128; k < w * 128 + 128; ++k) {
      const float cv = p.c[k];
      const float sv = cv / (1.f + __expf(-cv));
      const f32x4 wv = __builtin_nontemporal_load((const f32x4*)(wp + (size_t)k * 6144));
      a.x += sv * wv[0]; a.y += sv * wv[1]; a.z += sv * wv[2]; a.w += sv * wv[3];
    }
    *(float4*)(red + w * 256 + lane * 4) = a;
    __syncthreads();
    if (tid < 256) {
      float v = p.ada_b[l * 6144 + cb * 256 + tid];
#pragma unroll
      for (int q = 0; q < 8; ++q) v += red[q * 256 + tid];
      ((float*)(p.ws + WS_MOD))[l * 6144 + cb * 256 + tid] = v;
    }
    __syncthreads();
  }
  {
    const int half = tid >> 8, t2 = tid & 255;
    float* tile = (float*)(lds + half * 16640);
    const int kr0 = t2 >> 4, nc = (t2 & 15) * 4;
    Job jb; int k0 = 0, n0 = 0;
    f32x4 vq[4];
    int it = blockIdx.x;
    bool have = it < N_TR_TILES / 2;
    if (have) {
      int t = it * 2 + half, j = 0;
      for (;;) { const int nt = job_tiles(j); if (t < nt) break; t -= nt; ++j; }
      jb = get_job(p, j);
      const int ntn = jb.N >> 6;
      k0 = (t / ntn) * 64; n0 = (t % ntn) * 64;
#pragma unroll
      for (int i = 0; i < 4; ++i) vq[i] = __builtin_nontemporal_load((const f32x4*)(jb.src + (size_t)(k0 + kr0 + 16 * i) * jb.N + n0 + nc));
    }
    while (have) {
      const Job jc = jb; const int kc0 = k0, nc0 = n0;
      f32x4 vc[4];
#pragma unroll
      for (int i = 0; i < 4; ++i) vc[i] = vq[i];
      it += gridDim.x;
      have = it < N_TR_TILES / 2;
      if (have) {
        int t = it * 2 + half, j = 0;
        for (;;) { const int nt = job_tiles(j); if (t < nt) break; t -= nt; ++j; }
        jb = get_job(p, j);
        const int ntn = jb.N >> 6;
        k0 = (t / ntn) * 64; n0 = (t % ntn) * 64;
#pragma unroll
        for (int i = 0; i < 4; ++i) vq[i] = __builtin_nontemporal_load((const f32x4*)(jb.src + (size_t)(k0 + kr0 + 16 * i) * jb.N + n0 + nc));
      }
      __syncthreads();
#pragma unroll
      for (int i = 0; i < 4; ++i) {
        const int kr = kr0 + 16 * i;
        f32x4 v = vc[i];
        if (jc.scale) { const float s = jc.scale[kc0 + kr]; v *= s; }
        tile[kr * 65 + nc] = v[0]; tile[kr * 65 + nc + 1] = v[1]; tile[kr * 65 + nc + 2] = v[2]; tile[kr * 65 + nc + 3] = v[3];
      }
      __syncthreads();
#pragma unroll
      for (int i = 0; i < 2; ++i) {
        const int n = (t2 >> 3) + 32 * i, kc = (t2 & 7) * 8;
        uint4 u;
        u.x = pk_bf16(tile[(kc + 0) * 65 + n], tile[(kc + 1) * 65 + n]);
        u.y = pk_bf16(tile[(kc + 2) * 65 + n], tile[(kc + 3) * 65 + n]);
        u.z = pk_bf16(tile[(kc + 4) * 65 + n], tile[(kc + 5) * 65 + n]);
        u.w = pk_bf16(tile[(kc + 6) * 65 + n], tile[(kc + 7) * 65 + n]);
        const int ng = nc0 + n;
        int R = ng;
        if (jc.mode == 1) R = 64 * (ng >> 5) + (ng & 31);
        else if (jc.mode == 2) R = 64 * (ng >> 5) + 32 + (ng & 31);
        else if (jc.mode == 3) R = ((ng & 128) ? 1024 : 0) + (ng >> 8) * 128 + (ng & 127);
        *(uint4*)(jc.dst + (size_t)R * jc.K + kc0 + kc) = u;
      }
    }
  }
  if (blockIdx.x == gridDim.x - 1) {
    float* idv = (float*)(p.ws + WS_ID);
    for (int i = tid; i < D; i += NT) { idv[i] = 1.0f; idv[D + i] = 0.0f; }
  }
  {
    bf16_t* wb = (bf16_t*)(p.ws + WS_W);
    const uint4 z = {0u, 0u, 0u, 0u};
    for (int i = blockIdx.x * NT + tid; i < 2 * 8192; i += gridDim.x * NT) {
      const int jj = i >> 13, o = i & 8191;
      *(uint4*)(wb + MLA_BASE + jj * MLA_L + (size_t)704 * D + (size_t)o * 8) = z;
    }
  }
}

#define XB_TMO      128
#define XB_XCNT(j)  (256  + 64 * (j))
#define XB_XSUB(j)  (1280 + 64 * (j))
#define XB_XGEN(j)  (2304 + 64 * (j))
#define XB_TOP      3328
#define XB_TOPGEN   3392
#define XCD_BAR_WORDS 3456
#define XB_SPIN_CAP (1u << 18)
#define LAS __attribute__((address_space(3)))
DI unsigned xb_ld(unsigned* p) { return __hip_atomic_load(p, __ATOMIC_RELAXED, __HIP_MEMORY_SCOPE_AGENT); }
DI unsigned xb_add(unsigned* p, unsigned v) { return __hip_atomic_fetch_add(p, v, __ATOMIC_RELAXED, __HIP_MEMORY_SCOPE_AGENT); }
DI unsigned xb_xcc_id() { return (unsigned)__builtin_amdgcn_s_getreg((3 << 11) | 20) & 0xFu; }
#define XB_SPIN(cond, bar) do { unsigned _sp = 0; while (cond) { __builtin_amdgcn_s_sleep(1); \
    if ((++_sp & 255u) == 0u) { if (xb_ld(&(bar)[XB_TMO])) break; if (_sp > XB_SPIN_CAP) { atomicAdd(&(bar)[XB_TMO], 1u); break; } } } } while (0)
struct XcdBarrier { unsigned* bar; unsigned x; volatile LAS unsigned* st; };
DI XcdBarrier xcd_barrier_post(unsigned* bar, volatile LAS unsigned* st) {
  XcdBarrier b; b.bar = bar; b.x = xb_xcc_id(); b.st = st;
  if (threadIdx.x == 0) (void)xb_add(&bar[XB_XCNT(b.x)], 1u);
  return b;
}
DI void xcd_barrier_complete(unsigned* bar, unsigned x, unsigned& nloc, unsigned& nx) {
  const unsigned G = gridDim.x * gridDim.y * gridDim.z;
  unsigned sum, cnt, mine, sp = 0u;
  for (;;) {
    sum = 0u; cnt = 0u; mine = 0u;
#pragma unroll
    for (unsigned j = 0; j < 16; ++j) { const unsigned c = xb_ld(&bar[XB_XCNT(j)]); sum += c; cnt += (c > 0u) ? 1u : 0u; mine = (j == x) ? c : mine; }
    if (sum == G) break;
    __builtin_amdgcn_s_sleep(1);
    if ((++sp & 255u) == 0u) { if (xb_ld(&bar[XB_TMO])) break; if (sp > XB_SPIN_CAP) { atomicAdd(&bar[XB_TMO], 1u); break; } }
  }
  nloc = mine > 0u ? mine : 1u; nx = cnt > 0u ? cnt : 1u;
}
DI void xcd_barrier(const XcdBarrier& b, const int g_wave) {
  asm volatile("s_waitcnt vmcnt(0)" ::: "memory");
  __syncthreads();
  if (TID == 0) {
    size_t bz = 0; unsigned bx = b.x;
    asm volatile("" : "+s"(bz), "+s"(bx));
    unsigned* bar = b.bar + bz;
    __builtin_amdgcn_s_waitcnt(0);
    unsigned nloc = b.st[0], nx = b.st[1];
    if (nloc == 0u) { xcd_barrier_complete(bar, bx, nloc, nx); b.st[0] = nloc; b.st[1] = nx; }
    const unsigned old = xb_add(&bar[XB_XSUB(bx)], 1u);
    const unsigned gen = old / nloc;
    if (old + 1u == (gen + 1u) * nloc) {
      __builtin_amdgcn_fence(__ATOMIC_RELEASE, "agent");
      asm volatile("s_waitcnt vmcnt(0)" ::: "memory");
      const unsigned og = xb_add(&bar[XB_TOP], 1u);
      const unsigned tg = og / nx;
      if (og + 1u == (tg + 1u) * nx) xb_add(&bar[XB_TOPGEN], 1u);
      else XB_SPIN(xb_ld(&bar[XB_TOPGEN]) == tg, bar);
      __builtin_amdgcn_fence(__ATOMIC_ACQUIRE, "agent");
      xb_add(&bar[XB_XGEN(bx)], 1u);
      asm volatile("s_waitcnt vmcnt(0)" ::: "memory");
    } else {
      XB_SPIN(xb_ld(&bar[XB_XGEN(bx)]) == gen, bar);
      __builtin_amdgcn_fence(__ATOMIC_ACQUIRE, "agent");
      asm volatile("s_waitcnt vmcnt(0)" ::: "memory");
    }
  }
  __syncthreads();
}

__global__ void __launch_bounds__(NT) fwd_megakernel(Params p) {
  extern __shared__ __attribute__((aligned(1024))) unsigned char lds[];
  cg::grid_group grid = cg::this_grid();
  const int g_wave = __builtin_amdgcn_readfirstlane((int)(threadIdx.x >> 6));
  __shared__ uint4 xb_words;
  if (threadIdx.x == 0) xb_words = make_uint4(0u, 0u, 0u, 0u);
  __syncthreads();
  XcdBarrier xb = xcd_barrier_post((unsigned*)(p.ws + WS_BAR), (volatile LAS unsigned*)&xb_words);
  if (p.out == nullptr) grid.sync();
  const int G = gridDim.x, bid = blockIdx.x;
#define WSL size_t wz_ = 0; asm volatile("" : "+s"(wz_)); unsigned char* ws_ = p.ws + wz_;
#define P_WB ((bf16_t*)(ws_ + WS_W))
#define P_MOD ((float*)(ws_ + WS_MOD))
#define P_RINV ((float*)(ws_ + WS_RINV))
#define P_XZ ((float*)(ws_ + WS_XZ))
#define P_HB ((bf16_t*)(ws_ + WS_H))
#define P_LAT ((bf16_t*)(ws_ + WS_U + U_LAT))
#define P_Q ((bf16_t*)(ws_ + WS_U + U_Q))
#define P_K ((bf16_t*)(ws_ + WS_U + U_K))
#define P_VT ((bf16_t*)(ws_ + WS_U + U_VT))
#define P_O ((bf16_t*)(ws_ + WS_U + U_O))
#define P_ACT ((bf16_t*)(ws_ + WS_U + U_ACT))
#define P_STATS ((float*)(ws_ + WS_STATS))
#define P_ID ((const float*)(ws_ + WS_ID))

  phase0(p, lds, g_wave);
  xcd_barrier(xb, g_wave);
  { WSL; rowwise_phase<false>(p.x, nullptr, P_HB, nullptr, nullptr, P_MOD + 0, P_MOD + 1024, P_STATS, g_wave); }
  xcd_barrier(xb, g_wave);

#pragma unroll 1
  for (int li = 0; li < DEPTH; ++li) {
    const int jj = li >> 1;
    if ((li & 1) == 0) {
      {
        WSL; const bf16_t* w_in = P_WB + MLA_BASE + jj * MLA_L;
        EpiArgs e{}; e.o0 = P_LAT; e.o1 = P_K; e.pos = p.pos;
        for (int L = bid; L < 64 * 3; L += G) { int pm, pn; tile_map(L, 64, 3, pm, pn); gemm_tile<E_LAT>(P_HB, D, w_in, D, D, pm * 256, pn * 256, lds, e, g_wave); }
      }
      xcd_barrier(xb, g_wave);
      { WSL; rinv_phase(P_LAT, P_RINV, P_RINV + S, p.pos, P_K, g_wave); }
      xcd_barrier(xb, g_wave);
      {
        WSL; const bf16_t* w_in = P_WB + MLA_BASE + jj * MLA_L;
        EpiArgs e{}; e.o0 = P_Q; e.o1 = P_K; e.o2 = P_VT; e.pos = p.pos;
        for (int L = bid; L < 64 * 14; L += G) {
          int pm, pn; tile_map(L, 64, 14, pm, pn);
          if (pn < 6) { e.rinv = P_RINV; gemm_tile<E_Q>(P_LAT, 768, w_in + W_QB_OFF, 384, 384, pm * 256, pn * 256, lds, e, g_wave); }
          else if (pn < 10) { e.rinv = P_RINV + S; gemm_tile<E_KN>(P_LAT + 384, 768, w_in + W_KVB_OFF, 256, 256, pm * 256, (pn - 6) * 256, lds, e, g_wave); }
          else { e.rinv = P_RINV + S; gemm_tile<E_V>(P_LAT + 384, 768, w_in + W_KVB_OFF + 1024 * 256, 256, 256, pm * 256, (pn - 10) * 256, lds, e, g_wave); }
        }
      }
      xcd_barrier(xb, g_wave);
      {
        WSL;
        const int nround = (512 + G - 1) / G;
        for (int rep_ = 0; rep_ < R_ATT; ++rep_)
        for (int rr = 0; rr < nround; ++rr) {
          const int j = (rr & 1) ? ((rr + 1) * G - 1 - bid) : (rr * G + bid);
          if (j < 512) {
            const int qblk = 63 - (j >> 3), hd = j & 7;
            attn_item<192, 128, 64>(P_Q + hd * 192, 1536, P_K + (size_t)hd * S * 192, P_VT + (size_t)hd * 128 * S, P_O + hd * 128, 1024,
                                    qblk * 256, 0, qblk * 256 + 256, 1 << 30, -1e30f, 0.f, lds, g_wave);
          }
        }
      }
      xcd_barrier(xb, g_wave);
      {
        WSL; const bf16_t* w_in = P_WB + MLA_BASE + jj * MLA_L;
        EpiArgs e{}; e.xz = P_XZ; e.xsrc = (li == 0) ? p.x : P_XZ; e.gate = P_MOD + li * 6144 + 2048; e.bias = nullptr;
        e.stats = P_STATS; e.lng = (li == 0) ? P_ID : (p.ln_ffn_g + (li - 1) * D); e.lnb = (li == 0) ? (P_ID + D) : (p.ln_ffn_b + (li - 1) * D);
        for (int L = bid; L < 64 * 4; L += G) { int pm, pn; tile_map(L, 64, 4, pm, pn); gemm_tile<E_RES>(P_O, D, w_in + W_MO_OFF, D, D, pm * 256, pn * 256, lds, e, g_wave); }
      }
      xcd_barrier(xb, g_wave);
    } else {
      {
        WSL; const bf16_t* w_qkv = P_WB + SWA_BASE + jj * SWA_L;
        EpiArgs e{}; e.o0 = P_Q; e.o1 = P_K; e.o2 = P_VT; e.pos = p.pos; e.bias = p.swa_b_qkv + jj * 1536;
        const int nfull = (64 * 6 / G) * G, nrem = 64 * 6 - nfull;
        for (int L = bid; L < nfull; L += G) {
          int pm, pn; tile_map(L, 64, 6, pm, pn);
          if (pn < 5) gemm_tile<E_QK>(P_HB, D, w_qkv, D, D, pm * 256, pn * 256, lds, e, g_wave);
          else gemm_tile<E_SV>(P_HB, D, w_qkv + 1280 * D, D, D, pm * 256, 0, lds, e, g_wave);
        }
        for (int ix = bid; ix < 2 * nrem; ix += G) {
          int pm, pn; tile_map(nfull + (ix >> 1), 64, 6, pm, pn);
          const int m0h = pm * 256 + (ix & 1) * 128;
          if (pn < 5) gemm_tile<E_QK, 4>(P_HB, D, w_qkv, D, D, m0h, pn * 256, lds, e, g_wave);
          else gemm_tile<E_SV, 4>(P_HB, D, w_qkv + 1280 * D, D, D, m0h, 0, lds, e, g_wave);
        }
      }
      xcd_barrier(xb, g_wave);
      {
        WSL;
        for (int it = bid; it < 1024; it += G) {
          const int hq = it & 15, qblk = it >> 4, kvh = hq >> 2;
          const int kb0 = qblk > 0 ? qblk * 256 - 128 : 0;
          attn_item<64, 64, 64>(P_Q + hq * 64, 1024, P_K + (size_t)kvh * S * 64, P_VT + (size_t)kvh * 64 * S, P_O + hq * 64, 1024,
                                qblk * 256, kb0, qblk * 256 + 256, 128, p.swa_sinks[jj * 16 + hq] * LOG2E, 1.0f, lds, g_wave);
        }
      }
      xcd_barrier(xb, g_wave);
      {
        WSL; const bf16_t* w_qkv = P_WB + SWA_BASE + jj * SWA_L;
        EpiArgs e{}; e.xz = P_XZ; e.xsrc = P_XZ; e.gate = P_MOD + li * 6144 + 2048; e.bias = p.swa_b_o + jj * D;
        e.stats = P_STATS; e.lng = p.ln_ffn_g + (li - 1) * D; e.lnb = p.ln_ffn_b + (li - 1) * D;
        for (int L = bid; L < 64 * 4; L += G) { int pm, pn; tile_map(L, 64, 4, pm, pn); gemm_tile<E_RES>(P_O, D, w_qkv + W_SO_OFF, D, D, pm * 256, pn * 256, lds, e, g_wave); }
      }
      xcd_barrier(xb, g_wave);
    }
    { WSL; const float* md = P_MOD + li * 6144; rowwise_phase<true>(P_XZ, nullptr, P_HB, p.ln_mix_g + li * D, p.ln_mix_b + li * D, md + 3072, md + 4096, P_STATS, g_wave); }
    xcd_barrier(xb, g_wave);
    {
      WSL; EpiArgs e{}; e.o0 = P_ACT;
      const bf16_t* wgu = P_WB + li * FFN_L;
      const int nfull = (64 * 22 / G) * G, nrem = 64 * 22 - nfull;
      {
        bool pre = false;
        for (int L = bid; L < nfull; L += G) {
          int pm, pn, qm = -1, qn = 0;
          tile_map(L, 64, 22, pm, pn);
          if (L + G < nfull) { tile_map(L + G, 64, 22, qm, qn); qm *= 256; qn *= 256; }
          gemm_tile<E_SWIGLU>(P_HB, D, wgu, D, D, pm * 256, pn * 256, lds, e, g_wave, pre, qm, qn);
          pre = (qm >= 0);
        }
      }
      for (int ix = bid; ix < 2 * nrem; ix += G) { int pm, pn; tile_map(nfull + (ix >> 1), 64, 22, pm, pn); gemm_tile<E_SWIGLU, 4>(P_HB, D, wgu, D, D, pm * 256 + (ix & 1) * 128, pn * 256, lds, e, g_wave); }
    }
    xcd_barrier(xb, g_wave);
    {
      WSL; EpiArgs e{}; e.xz = P_XZ; e.xsrc = P_XZ; e.gate = P_MOD + li * 6144 + 5120; e.bias = nullptr;
      e.stats = P_STATS; e.lng = p.ln_mix_g + li * D; e.lnb = p.ln_mix_b + li * D;
      const bf16_t* wdn = P_WB + li * FFN_L + W_DN_OFF;
      {
        for (int L = bid; L < 64 * 4; L += G) { int pm, pn; tile_map(L, 64, 4, pm, pn); gemm_tile<E_RES>(P_ACT, F, wdn, F, F, pm * 256, pn * 256, lds, e, g_wave); }
      }
    }
    xcd_barrier(xb, g_wave);
    {
      WSL; const float* md = P_MOD + li * 6144;
      if (li + 1 < DEPTH) rowwise_phase<true>(P_XZ, nullptr, P_HB, p.ln_ffn_g + li * D, p.ln_ffn_b + li * D, md + 6144, md + 6144 + 1024, P_STATS, g_wave);
      else rowwise_phase<true>(P_XZ, p.out, nullptr, p.ln_ffn_g + li * D, p.ln_ffn_b + li * D, nullptr, nullptr, nullptr, g_wave);
    }
    if (li + 1 < DEPTH) xcd_barrier(xb, g_wave);
  }
}

extern "C" void kernel_launch(void* const* d_in, const int* in_sizes, int n_in, void* d_out, int out_size, void* d_ws, size_t ws_size,
                              hipStream_t stream) {
  static int grid_blocks = 0;
  if (grid_blocks == 0) {
    if (n_in != 23 || out_size != S * D || ws_size < WS_END) {
      fprintf(stderr, "kernel_launch: unexpected shapes (n_in %d out %d ws %zu need %zu)\n", n_in, out_size, ws_size, (size_t)WS_END);
      grid_blocks = -1; return;
    }
    int dev = 0, cus = 0, per_cu = 0;
    (void)hipGetDevice(&dev);
    (void)hipDeviceGetAttribute(&cus, hipDeviceAttributeMultiprocessorCount, dev);
    (void)hipFuncSetAttribute((const void*)fwd_megakernel, hipFuncAttributeMaxDynamicSharedMemorySize, LDS_BYTES);
    (void)hipOccupancyMaxActiveBlocksPerMultiprocessor(&per_cu, (const void*)fwd_megakernel, NT, LDS_BYTES);
    if (per_cu < 1) { fprintf(stderr, "kernel_launch: occupancy query returned %d\n", per_cu); per_cu = 1; }
    per_cu = 1;
    grid_blocks = cus * per_cu;
  }
  if (grid_blocks < 0) return;
  Params p{};
  p.x = (const float*)d_in[0]; p.c = (const float*)d_in[1]; p.pos = (const int*)d_in[2];
  p.ada_w = (const float*)d_in[3]; p.ada_b = (const float*)d_in[4];
  p.ln_mix_g = (const float*)d_in[5]; p.ln_mix_b = (const float*)d_in[6]; p.ln_ffn_g = (const float*)d_in[7]; p.ln_ffn_b = (const float*)d_in[8];
  p.ffn_w_gate = (const float*)d_in[9]; p.ffn_w_up = (const float*)d_in[10]; p.ffn_w_down = (const float*)d_in[11];
  p.mla_w_in = (const float*)d_in[12]; p.mla_q_norm = (const float*)d_in[13]; p.mla_w_q_b = (const float*)d_in[14];
  p.mla_kv_norm = (const float*)d_in[15]; p.mla_w_kv_b = (const float*)d_in[16]; p.mla_w_o = (const float*)d_in[17];
  p.swa_w_qkv = (const float*)d_in[18]; p.swa_b_qkv = (const float*)d_in[19]; p.swa_sinks = (const float*)d_in[20];
  p.swa_w_o = (const float*)d_in[21]; p.swa_b_o = (const float*)d_in[22];
  p.out = (float*)d_out; p.ws = (unsigned char*)d_ws;
  (void)hipMemsetAsync((unsigned char*)d_ws + WS_BAR, 0, XCD_BAR_WORDS * 4, stream);
  void* args[] = {&p};
  hipError_t e = hipLaunchCooperativeKernel((const void*)fwd_megakernel, dim3(grid_blocks), dim3(NT), args, LDS_BYTES, stream);
  if (e != hipSuccess) fprintf(stderr, "cooperative launch failed: %s (grid %d)\n", hipGetErrorString(e), grid_blocks);
}
```
